# Optimizing an MI355X kernel written in HIP

```python
import math
import jax, jax.numpy as jnp
from jax import lax
import numpy as np

D_MODEL = 1024
BATCH = 16
SEQ = 4096
DEPTH = 4

GRID_W = 64
CTX_LEN = 256
N_MIXERS = 2
N_ATTN_LAYERS = (DEPTH + 1) // 2
N_HGRN_LAYERS = DEPTH // 2
EPS = 1e-6

HEAD_DIM = 64
N_HEADS = D_MODEL // HEAD_DIM
N_KV_HEADS = 4
GROUP = N_HEADS // N_KV_HEADS
WINDOW = 128
BLOCK = 128
ROPE_THETA = 10000.0
ATTN_IN_W = (N_HEADS + 2 * N_KV_HEADS) * HEAD_DIM

HG_EXPAND = 128
HG_HEADS = D_MODEL // HG_EXPAND
HG_DK = HG_EXPAND
HG_DV = D_MODEL // HG_HEADS
HG_DF = HG_HEADS * HG_DK
HG_CHUNK = 32
HG_SPLITS = [HG_DF, 2 * HG_DF, 3 * HG_DF, 3 * HG_DF + D_MODEL]
HG_IN_W = 3 * HG_DF + 2 * D_MODEL

D_FF = 2816
CONV_W = 3

kernel_name = 'hybrid_swa_hgrn2_convglu_dit'


def rms_norm(x, gain):
    xf = x.astype(jnp.float32)
    y = xf * lax.rsqrt(jnp.mean(xf * xf, axis=-1, keepdims=True) + EPS)
    return (y * gain.astype(jnp.float32)).astype(x.dtype)


def axial_angles(rows):
    row = jnp.repeat(jnp.arange(rows, dtype=jnp.float32), GRID_W)
    col = jnp.tile(jnp.arange(GRID_W, dtype=jnp.float32), rows)
    n_pairs = HEAD_DIM // 4
    inv = ROPE_THETA ** (-jnp.arange(n_pairs, dtype=jnp.float32) / n_pairs)
    return row[:, None] * inv, col[:, None] * inv


def rope_rotate(x, ang):
    x1, x2 = jnp.split(x, 2, axis=-1)
    cos = jnp.cos(ang)[None, :, None, :].astype(x.dtype)
    sin = jnp.sin(ang)[None, :, None, :].astype(x.dtype)
    return jnp.concatenate([x1 * cos - x2 * sin, x1 * sin + x2 * cos], axis=-1)


def apply_axial_rope(x, ang_r, ang_c):
    xr, xc = jnp.split(x, 2, axis=-1)
    return jnp.concatenate([rope_rotate(xr, ang_r), rope_rotate(xc, ang_c)], axis=-1)


def sink_softmax(scores, sink_g):
    s_sink = jnp.broadcast_to(sink_g[None, :, :, None, None].astype(jnp.float32), scores.shape[:-1] + (1,))
    p = jax.nn.softmax(jnp.concatenate([scores, s_sink], axis=-1), axis=-1)
    return p[..., :-1]


def attn_project(h, w_in, q_gain, k_gain):
    b, t, _ = h.shape
    q, k, v = jnp.split(h @ w_in, [N_HEADS * HEAD_DIM, (N_HEADS + N_KV_HEADS) * HEAD_DIM], axis=-1)
    q = rms_norm(q.reshape(b, t, N_HEADS, HEAD_DIM), q_gain)
    k = rms_norm(k.reshape(b, t, N_KV_HEADS, HEAD_DIM), k_gain)
    v = v.reshape(b, t, N_KV_HEADS, HEAD_DIM)
    return q, k, v


def windowed_gqa(hx, hc, w_in, w_out, q_gain, k_gain, sink, ang_r, ang_c, need_ctx_out):
    B, L, _ = hx.shape
    nb = L // BLOCK
    scale = HEAD_DIM ** -0.5
    qx, kx, vx = attn_project(hx, w_in, q_gain, k_gain)
    qc, kc, vc = attn_project(hc, w_in, q_gain, k_gain)
    qx = apply_axial_rope(qx, ang_r, ang_c)
    kx = apply_axial_rope(kx, ang_r, ang_c)
    kc_t = kc.transpose(0, 2, 1, 3)
    vc_t = vc.transpose(0, 2, 1, 3)
    pad = ((0, 0), (0, 0), (BLOCK, BLOCK), (0, 0))
    kx_p = jnp.pad(kx.transpose(0, 2, 1, 3), pad)
    vx_p = jnp.pad(vx.transpose(0, 2, 1, 3), pad)
    q_blocks = qx.reshape(B, nb, BLOCK, N_KV_HEADS, GROUP, HEAD_DIM).transpose(1, 0, 3, 4, 2, 5)
    sink_g = sink.reshape(N_KV_HEADS, GROUP)
    q_off = jnp.arange(BLOCK, dtype=jnp.int32)
    k_off = jnp.arange(3 * BLOCK, dtype=jnp.int32) - BLOCK

    def block(args):
        n, qb = args
        start = n * BLOCK
        kb = lax.dynamic_slice_in_dim(kx_p, start, 3 * BLOCK, axis=2)
        vb = lax.dynamic_slice_in_dim(vx_p, start, 3 * BLOCK, axis=2)
        qi = start + q_off
        kj = start + k_off
        valid = ((kj >= 0) & (kj < L))[None, :] & (jnp.abs(qi[:, None] - kj[None, :]) <= WINDOW)
        s_win = jnp.einsum('bkgqd,bkjd->bkgqj', qb, kb).astype(jnp.float32) * scale
        s_win = jnp.where(valid, s_win, -jnp.inf)
        s_ctx = jnp.einsum('bkgqd,bkcd->bkgqc', qb, kc_t).astype(jnp.float32) * scale
        p = sink_softmax(jnp.concatenate([s_win, s_ctx], axis=-1), sink_g).astype(vb.dtype)
        return (jnp.einsum('bkgqj,bkjd->bkgqd', p[..., :3 * BLOCK], vb)
                + jnp.einsum('bkgqc,bkcd->bkgqd', p[..., 3 * BLOCK:], vc_t))

    o = lax.map(block, (jnp.arange(nb, dtype=jnp.int32), q_blocks))
    ox = o.transpose(1, 0, 4, 2, 3, 5).reshape(B, L, N_HEADS * HEAD_DIM)
    yc = None
    if need_ctx_out:
        C = hc.shape[1]
        qcg = qc.reshape(B, C, N_KV_HEADS, GROUP, HEAD_DIM).transpose(0, 2, 3, 1, 4)
        s = jnp.einsum('bkgqd,bkcd->bkgqc', qcg, kc_t).astype(jnp.float32) * scale
        p = sink_softmax(s, sink_g).astype(vc.dtype)
        oc = jnp.einsum('bkgqc,bkcd->bkgqd', p, vc_t).transpose(0, 3, 1, 2, 4).reshape(B, C, N_HEADS * HEAD_DIM)
        yc = oc @ w_out
    return ox @ w_out, yc


def chunk_scan(q, k, g, v, s0, need_out):
    B, T, H, dk = q.shape
    dv = v.shape[-1]
    n = T // HG_CHUNK

    def to_chunks(a):
        return a.reshape(B, n, HG_CHUNK, H, a.shape[-1]).transpose(1, 0, 3, 2, 4).astype(jnp.float32)

    tri = jnp.tril(jnp.ones((HG_CHUNK, HG_CHUNK), dtype=bool))

    def step(S, inp):
        qc, kc, gc, vc = inp
        b = jnp.cumsum(gc, axis=2)
        b_last = b[:, :, -1:, :]
        k_dec = kc * jnp.exp(b_last - b)
        S_new = jnp.exp(b_last[:, :, 0, :])[..., None] * S + jnp.einsum('bhck,bhcv->bhkv', k_dec, vc)
        if not need_out:
            return S_new, None
        o_inter = jnp.einsum('bhck,bhkv->bhcv', qc * jnp.exp(b), S)
        diff = jnp.where(tri[:, :, None], b[:, :, :, None, :] - b[:, :, None, :, :], -jnp.inf)
        a = jnp.einsum('bhtk,bhsk,bhtsk->bhts', qc, kc, jnp.exp(diff))
        return S_new, o_inter + jnp.einsum('bhts,bhsv->bhtv', a, vc)

    S_fin, o = lax.scan(step, s0, (to_chunks(q), to_chunks(k), to_chunks(g), to_chunks(v)))
    if need_out:
        o = o.transpose(1, 0, 3, 2, 4).reshape(B, T, H, dv)
    return o, S_fin


def hgrn2_bidir(hx, hc, w_in, w_out, o_gain, lb, need_ctx_out):
    def project(h):
        b, t, _ = h.shape
        q, f_fw, f_bw, inp, gate = jnp.split(h @ w_in, HG_SPLITS, axis=-1)
        q = jax.nn.silu(q).reshape(b, t, HG_HEADS, HG_DK)
        inp = inp.reshape(b, t, HG_HEADS, HG_DV)

        def forget(fl):
            f = lb + (1.0 - lb) * jax.nn.sigmoid(fl.astype(jnp.float32))
            return (1.0 - f).reshape(b, t, HG_HEADS, HG_DK), jnp.log(f).reshape(b, t, HG_HEADS, HG_DK)

        return q, forget(f_fw), forget(f_bw), inp, gate

    flip = lambda a: jnp.flip(a, axis=1)
    qx, (kxf, gxf), (kxb, gxb), vx, gx = project(hx)
    qc, (kcf, gcf), (kcb, gcb), vc, gc = project(hc)
    s0 = jnp.zeros((hc.shape[0], HG_HEADS, HG_DK, HG_DV), jnp.float32)
    oc_f, sc_f = chunk_scan(qc, kcf, gcf, vc, s0, need_ctx_out)
    oc_b, sc_b = chunk_scan(flip(qc), flip(kcb), flip(gcb), flip(vc), s0, need_ctx_out)
    ox_f, _ = chunk_scan(qx, kxf, gxf, vx, sc_f, True)
    ox_b, _ = chunk_scan(flip(qx), flip(kxb), flip(gxb), flip(vx), sc_b, True)

    def readout(o, gate, h):
        o = rms_norm(o, o_gain).astype(h.dtype) * jax.nn.silu(gate).reshape(o.shape)
        return o.reshape(h.shape[0], h.shape[1], D_MODEL) @ w_out

    yx = readout(ox_f + flip(ox_b), gx, hx)
    yc = readout(oc_f + flip(oc_b), gc, hc) if need_ctx_out else None
    return yx, yc


def dwconv3(u, w, b):
    up = jnp.pad(u, ((0, 0), (1, 1), (0, 0)))
    return up[:, :-2] * w[0] + up[:, 1:-1] * w[1] + up[:, 2:] * w[2] + b


def conv_glu(h, w_up, conv_w, conv_b, w_down):
    gate, val = jnp.split(h @ w_up, 2, axis=-1)
    return (jax.nn.silu(dwconv3(gate, conv_w, conv_b)) * val) @ w_down


def setup_inputs(seed: int = 0) -> dict:
    key = jax.random.key(seed)
    ks = jax.random.split(key, 21)
    D = D_MODEL

    def nrm(k, shape, scale):
        return jax.random.normal(k, shape, jnp.float32) * scale

    def gain(k, shape):
        return 1.0 + 0.05 * jax.random.normal(k, shape, jnp.float32)

    return {
        'x': nrm(ks[0], (BATCH, SEQ, D), 1.0),
        'c': nrm(ks[1], (BATCH, D), 1.0),
        'ctx': nrm(ks[2], (BATCH, CTX_LEN, D), 1.0),
        'c_ctx': nrm(ks[3], (D,), 1.0),
        'ada_w': nrm(ks[4], (DEPTH, D, 6 * D), 0.5 * D ** -0.5),
        'ada_b': nrm(ks[5], (DEPTH, 6 * D), 0.02),
        'norm1_g': gain(ks[6], (DEPTH, D)),
        'norm2_g': gain(ks[7], (DEPTH, D)),
        'attn_w_in': nrm(ks[8], (N_ATTN_LAYERS, D, ATTN_IN_W), D ** -0.5),
        'attn_w_out': nrm(ks[9], (N_ATTN_LAYERS, N_HEADS * HEAD_DIM, D), (N_HEADS * HEAD_DIM) ** -0.5),
        'attn_q_gain': gain(ks[10], (N_ATTN_LAYERS, HEAD_DIM)),
        'attn_k_gain': gain(ks[11], (N_ATTN_LAYERS, HEAD_DIM)),
        'attn_sink': nrm(ks[12], (N_ATTN_LAYERS, N_HEADS), 0.5),
        'hgrn_w_in': nrm(ks[13], (N_HGRN_LAYERS, D, HG_IN_W), D ** -0.5),
        'hgrn_w_out': nrm(ks[14], (N_HGRN_LAYERS, D, D), D ** -0.5),
        'hgrn_o_gain': gain(ks[15], (N_HGRN_LAYERS, HG_DV)),
        'hgrn_lb_logits': nrm(ks[16], (DEPTH, HG_DF), 0.5),
        'ffn_w_up': nrm(ks[17], (DEPTH, D, 2 * D_FF), D ** -0.5),
        'ffn_conv_w': nrm(ks[18], (DEPTH, CONV_W, D_FF), CONV_W ** -0.5),
        'ffn_conv_b': nrm(ks[19], (DEPTH, D_FF), 0.02),
        'ffn_w_down': nrm(ks[20], (DEPTH, D_FF, D), D_FF ** -0.5),
    }


def reference(x, c, ctx, c_ctx, ada_w, ada_b, norm1_g, norm2_g, attn_w_in, attn_w_out, attn_q_gain,
              attn_k_gain, attn_sink, hgrn_w_in, hgrn_w_out, hgrn_o_gain, hgrn_lb_logits, ffn_w_up,
              ffn_conv_w, ffn_conv_b, ffn_w_down):
    L = x.shape[1]
    rows = L // GRID_W
    ang_r, ang_c = axial_angles(rows)
    lb_prob = jax.nn.softmax(hgrn_lb_logits.astype(jnp.float32), axis=0)
    lb_sched = jnp.cumsum(lb_prob, axis=0) - lb_prob[0]
    for layer in range(DEPTH):
        last = layer == DEPTH - 1
        j = layer // N_MIXERS
        mod = jax.nn.silu(c) @ ada_w[layer] + ada_b[layer]
        mod_c = jax.nn.silu(c_ctx) @ ada_w[layer] + ada_b[layer]
        sh1, sc1, g1, sh2, sc2, g2 = jnp.split(mod[:, None, :], 6, axis=-1)
        csh1, csc1, cg1, csh2, csc2, cg2 = jnp.split(mod_c, 6)
        hx = rms_norm(x, norm1_g[layer]) * (1.0 + sc1) + sh1
        hc = rms_norm(ctx, norm1_g[layer]) * (1.0 + csc1) + csh1
        if layer % N_MIXERS == 0:
            yx, yc = windowed_gqa(hx, hc, attn_w_in[j], attn_w_out[j], attn_q_gain[j], attn_k_gain[j],
                                  attn_sink[j], ang_r, ang_c, not last)
        else:
            yx, yc = hgrn2_bidir(hx, hc, hgrn_w_in[j], hgrn_w_out[j], hgrn_o_gain[j], lb_sched[layer], not last)
        x = x + g1 * yx
        hx2 = rms_norm(x, norm2_g[layer]) * (1.0 + sc2) + sh2
        x = x + g2 * conv_glu(hx2, ffn_w_up[layer], ffn_conv_w[layer], ffn_conv_b[layer], ffn_w_down[layer])
        if not last:
            ctx = ctx + cg1 * yc
            hc2 = rms_norm(ctx, norm2_g[layer]) * (1.0 + csc2) + csh2
            ctx = ctx + cg2 * conv_glu(hc2, ffn_w_up[layer], ffn_conv_w[layer], ffn_conv_b[layer], ffn_w_down[layer])
    return x
```

```cpp
#include <hip/hip_runtime.h>
#include <hip/hip_cooperative_groups.h>
#include <cstdio>
#include <cstdint>
namespace cg = cooperative_groups;
__device__ __forceinline__ int opaque_tid() { int t = threadIdx.x; asm volatile("" : "+v"(t)); return t; }
namespace pg8 {
#define PG8_LAS __attribute__((address_space(3)))
typedef unsigned short bf16_t;
typedef short bf16x8 __attribute__((ext_vector_type(8)));
typedef float f32x4 __attribute__((ext_vector_type(4)));
typedef unsigned u32x4 __attribute__((ext_vector_type(4)));
constexpr int BM = 256, BK = 64, HALF = 128, HTB = HALF * BK * 2  , STAGE_BYTES = 8 * HTB, NXCD = 8, WGM = 4;

__host__ __device__ __forceinline__ int lds_byte(int r, int c) { const int st = (r >> 4) * 2 + (c >> 5), rr = r & 15, cc = c & 31, ob = rr * 64 + cc * 2; return st * 1024 + (ob ^ (((ob >> 9) & 1) << 5)); }
__host__ __device__ __forceinline__ void stage_rc(int b, int& R, int& C) { const int st = b / 1024, sb = b % 1024, swz = sb ^ (((sb >> 9) & 1) << 5); R = (st >> 1) * 16 + swz / 64; C = (st & 1) * 32 + (swz % 64) / 2; }
__host__ __device__ __forceinline__ int perm32(int rho) { const int n = rho >> 4, i = rho & 15; return 8 * (i >> 2) + 4 * n + (i & 3); }

struct Unit { int pm, pn; };
struct Gemm { const bf16_t* A; const bf16_t* Bt; int M, N, K, lda; };

struct StaticOrder {
    int nM, nN, nwg, G, c;
    __host__ __device__ void init(int M, int N, int G_, int c_) { nM = M / BM; nN = N / BM; nwg = nM * nN; G = G_; c = c_; }
    __host__ __device__ bool next(int i, Unit& u) const {
        const long L = (long)i * G + c; if (L >= nwg) return false;
        int wgid = (int)L; { const int q = nwg / NXCD, r = nwg % NXCD, xcd = wgid % NXCD, off = wgid / NXCD; wgid = (xcd < r ? xcd * (q + 1) : r * (q + 1) + (xcd - r) * q) + off; }
        const int nig = WGM * nN, gid = wgid / nig, fm = gid * WGM, gsz = (nM - fm) < WGM ? (nM - fm) : WGM;
        u.pm = fm + ((wgid % nig) % gsz); u.pn = (wgid % nig) / gsz; return true;
    }
    __device__ __forceinline__ void a_ready(const Unit&) const {}
    __device__ __forceinline__ void done(const Unit&) const {}
};

template <class Epi, class Sched, bool ALIGN_EPI = false, bool SP2 = false>
__device__ __forceinline__ void gemm_phase(PG8_LAS unsigned char* lds, const Gemm g, const Sched& S, const Epi& E) {
    const int tid = opaque_tid(), wid = __builtin_amdgcn_readfirstlane(tid >> 6), lane = tid & 63, wr = wid >> 2, wc = wid & 3, fr = lane & 15, fq = lane >> 4;
    const int K = g.K, nt = K / BK;
    unsigned voffA[2], voffB[2];
#pragma unroll
    for (int i = 0; i < 2; ++i) { int R, C; stage_rc(tid * 16 + i * 8192, R, C); const int Rb = Epi::PERM ? ((R & ~31) + perm32(R & 31)) : R;
        voffA[i] = (unsigned)(R * g.lda + C) * 2u; voffB[i] = (unsigned)(Rb * K + C) * 2u; }
    const size_t kstep = (size_t)(BK * 2);
    const size_t hstepA = (size_t)HALF * g.lda * 2, hstepB = (size_t)HALF * K * 2;
    const size_t tstepA = 2 * hstepA, tstepB = 2 * hstepB;
    const unsigned ldsw = (unsigned)wid * 1024u;
    const int aoff = lds_byte(wr * 64 + fr, fq * 8), boff = lds_byte(wc * 32 + fr, fq * 8);
#define PG8_SA(b, h) (((b) * 2 + (h)) * HTB)
#define PG8_SB(b, h) ((4 + (b) * 2 + (h)) * HTB)
#define PG8_STAGE(bufoff, gbase, voff) do { _Pragma("unroll") for (int _i = 0; _i < 2; ++_i) \
        __builtin_amdgcn_global_load_lds((const unsigned*)((const char*)(gbase) + (voff)[_i]), (PG8_LAS unsigned*)(lds + (bufoff) + ldsw + _i * 8192), 16, 0, 0); } while (0)
#define PG8_LDA(dst, b, h) do { _Pragma("unroll") for (int m = 0; m < 4; ++m) _Pragma("unroll") for (int k = 0; k < 2; ++k) dst[m][k] = *(const PG8_LAS bf16x8*)(lds + PG8_SA(b, h) + aoff + m * 2048 + k * 1024); } while (0)
#define PG8_LDB(dst, b, h) do { _Pragma("unroll") for (int n = 0; n < 2; ++n) _Pragma("unroll") for (int k = 0; k < 2; ++k) dst[n][k] = *(const PG8_LAS bf16x8*)(lds + PG8_SB(b, h) + boff + n * 2048 + k * 1024); } while (0)
#define PG8_MMA(ai, bj, At, Bt) do { __builtin_amdgcn_s_setprio(1); _Pragma("unroll") for (int m = 0; m < 4; ++m) _Pragma("unroll") for (int n = 0; n < 2; ++n) _Pragma("unroll") for (int k = 0; k < 2; ++k) \
        acc[ai][bj][m][n] = __builtin_amdgcn_mfma_f32_16x16x32_bf16(Bt[n][k], At[m][k], acc[ai][bj][m][n], 0, 0, 0); __builtin_amdgcn_s_setprio(0); } while (0)
#define PG8_WAIT_V(n) asm volatile("s_waitcnt vmcnt(" #n ")" ::: "memory")
#define PG8_WAIT_L(n) asm volatile("s_waitcnt lgkmcnt(" #n ")" ::: "memory")
#define PG8_BAR __builtin_amdgcn_s_barrier()
#define PG8_SCHED __builtin_amdgcn_sched_barrier(0)
    Unit cur, nxt; int ui = 0;
    if (!S.next(0, cur)) return;
    f32x4 acc[2][2][4][2];
#pragma unroll
    for (int a = 0; a < 2; ++a)
#pragma unroll
        for (int b = 0; b < 2; ++b)
#pragma unroll
            for (int m = 0; m < 4; ++m)
#pragma unroll
                for (int n = 0; n < 2; ++n) acc[a][b][m][n] = (f32x4){0.f, 0.f, 0.f, 0.f};
    bf16x8 At[4][2], B0[2][2], B1[2][2];
    const char* cA = (const char*)g.A + (size_t)cur.pm * tstepA; const char* cB = (const char*)g.Bt + (size_t)cur.pn * tstepB;
    S.a_ready(cur);
    if constexpr (SP2) {
        PG8_STAGE(PG8_SB(0, 0), cB, voffB); PG8_STAGE(PG8_SB(0, 1), cB + hstepB, voffB); PG8_STAGE(PG8_SA(0, 0), cA, voffA); PG8_STAGE(PG8_SA(0, 1), cA + hstepA, voffA);
        if (wr == 1) PG8_BAR;
        PG8_WAIT_V(2); PG8_BAR;
        PG8_STAGE(PG8_SB(1, 0), cB + kstep, voffB); PG8_STAGE(PG8_SA(1, 0), cA + kstep, voffA); PG8_STAGE(PG8_SB(1, 1), cB + hstepB + kstep, voffB);
        PG8_WAIT_V(6); PG8_BAR;
    } else {
        PG8_STAGE(PG8_SB(0, 0), cB, voffB); PG8_STAGE(PG8_SA(0, 0), cA, voffA); PG8_STAGE(PG8_SB(0, 1), cB + hstepB, voffB); PG8_STAGE(PG8_SA(0, 1), cA + hstepA, voffA);
        if (wr == 1) PG8_BAR;
        PG8_WAIT_V(4); PG8_BAR;
        PG8_STAGE(PG8_SB(1, 0), cB + kstep, voffB); PG8_STAGE(PG8_SA(1, 0), cA + kstep, voffA); PG8_STAGE(PG8_SB(1, 1), cB + hstepB + kstep, voffB);
        PG8_WAIT_V(6); PG8_BAR;
    }
    for (;;) {
        const bool has_next = S.next(ui + 1, nxt);
        const char* nA = has_next ? (const char*)g.A + (size_t)nxt.pm * tstepA : cA; const char* nB = has_next ? (const char*)g.Bt + (size_t)nxt.pn * tstepB : cB;
        for (int t = 0; t < nt; t += 2) {
            const bool last = (t == nt - 2);
            const char* a1 = cA + (size_t)(t + 1) * kstep;
            const char* a2 = last ? nA : cA + (size_t)(t + 2) * kstep; const char* b2 = last ? nB : cB + (size_t)(t + 2) * kstep;
            const char* a3 = a2 + kstep; const char* b3 = b2 + kstep;
            if (last && has_next) S.a_ready(nxt);
            if constexpr (SP2) {
            PG8_LDB(B0, 0, 0); PG8_LDB(B1, 0, 1); PG8_SCHED; PG8_LDA(At, 0, 0); PG8_STAGE(PG8_SA(1, 1), a1 + hstepA, voffA);
            PG8_WAIT_V(8); PG8_WAIT_L(0); PG8_BAR; PG8_MMA(0, 0, At, B0); PG8_MMA(0, 1, At, B1); PG8_BAR; PG8_SCHED;
            PG8_LDA(At, 0, 1); PG8_STAGE(PG8_SB(0, 0), b2, voffB); PG8_STAGE(PG8_SB(0, 1), b2 + hstepB, voffB); PG8_STAGE(PG8_SA(0, 0), a2, voffA);
            PG8_WAIT_V(8); PG8_WAIT_L(0); PG8_BAR; PG8_MMA(1, 0, At, B0); PG8_MMA(1, 1, At, B1); PG8_BAR; PG8_SCHED;
            PG8_LDB(B0, 1, 0); PG8_LDB(B1, 1, 1); PG8_SCHED; PG8_LDA(At, 1, 0); PG8_STAGE(PG8_SA(0, 1), a2 + hstepA, voffA);
            PG8_WAIT_V(8); PG8_WAIT_L(0); PG8_BAR; PG8_MMA(0, 0, At, B0); PG8_MMA(0, 1, At, B1); PG8_BAR; PG8_SCHED;
            PG8_LDA(At, 1, 1); PG8_STAGE(PG8_SB(1, 0), b3, voffB); PG8_STAGE(PG8_SB(1, 1), b3 + hstepB, voffB); PG8_STAGE(PG8_SA(1, 0), a3, voffA);
            PG8_WAIT_V(8); PG8_WAIT_L(0); PG8_BAR; PG8_MMA(1, 0, At, B0); PG8_MMA(1, 1, At, B1); PG8_BAR; PG8_SCHED;
            } else {
            PG8_LDB(B0, 0, 0); PG8_SCHED; PG8_LDA(At, 0, 0); PG8_STAGE(PG8_SA(1, 1), a1 + hstepA, voffA);
            PG8_WAIT_L(8); PG8_BAR; PG8_WAIT_L(0); PG8_MMA(0, 0, At, B0); PG8_BAR; PG8_SCHED;
            PG8_LDB(B1, 0, 1); PG8_STAGE(PG8_SB(0, 0), b2, voffB);
            PG8_BAR; PG8_WAIT_L(0); PG8_MMA(0, 1, At, B1); PG8_BAR;
            PG8_LDA(At, 0, 1); PG8_STAGE(PG8_SA(0, 0), a2, voffA);
            PG8_BAR; PG8_WAIT_L(0); PG8_MMA(1, 0, At, B0); PG8_BAR; PG8_SCHED;
            PG8_STAGE(PG8_SB(0, 1), b2 + hstepB, voffB);
            PG8_WAIT_V(6); PG8_BAR; PG8_MMA(1, 1, At, B1); PG8_BAR;
            PG8_LDB(B0, 1, 0); PG8_SCHED; PG8_LDA(At, 1, 0); PG8_STAGE(PG8_SA(0, 1), a2 + hstepA, voffA);
            PG8_WAIT_L(8); PG8_BAR; PG8_WAIT_L(0); PG8_MMA(0, 0, At, B0); PG8_BAR; PG8_SCHED;
            PG8_LDB(B1, 1, 1); PG8_STAGE(PG8_SB(1, 0), b3, voffB);
            PG8_BAR; PG8_WAIT_L(0); PG8_MMA(0, 1, At, B1); PG8_BAR;
            PG8_LDA(At, 1, 1); PG8_STAGE(PG8_SA(1, 0), a3, voffA);
            PG8_BAR; PG8_WAIT_L(0); PG8_MMA(1, 0, At, B0); PG8_BAR; PG8_SCHED;
            PG8_STAGE(PG8_SB(1, 1), b3 + hstepB, voffB);
            PG8_WAIT_V(6); PG8_BAR; PG8_MMA(1, 1, At, B1); PG8_BAR;
            }
        }
        if constexpr (ALIGN_EPI) { if (wr == 0) PG8_BAR; }
        if constexpr (!Epi::AFTER_DRAIN) { E(acc, cur, wr, wc, fr, fq); S.done(cur); }
        if (!has_next) break;
#pragma unroll
        for (int a = 0; a < 2; ++a)
#pragma unroll
            for (int b = 0; b < 2; ++b)
#pragma unroll
                for (int m = 0; m < 4; ++m)
#pragma unroll
                    for (int n = 0; n < 2; ++n) acc[a][b][m][n] = (f32x4){0.f, 0.f, 0.f, 0.f};
        cur = nxt; cA = nA; cB = nB; ++ui;
        if constexpr (ALIGN_EPI) { if (wr == 1) PG8_BAR; }
    }
    PG8_WAIT_V(0);
    if constexpr (!ALIGN_EPI) { if (wr == 0) PG8_BAR; }
    PG8_BAR;
    if constexpr (Epi::AFTER_DRAIN) { E.fused(acc, cur, wr, wc, fr, fq, lds, wid, lane); S.done(cur); }
#undef PG8_SA
#undef PG8_SB
#undef PG8_STAGE
#undef PG8_LDA
#undef PG8_LDB
#undef PG8_MMA
#undef PG8_WAIT_V
#undef PG8_WAIT_L
#undef PG8_BAR
#undef PG8_SCHED
}
}

#define LAS __attribute__((address_space(3)))
typedef unsigned short bf16;
typedef float f32x4 __attribute__((ext_vector_type(4)));
typedef float f32x2 __attribute__((ext_vector_type(2)));
typedef unsigned u32x4 __attribute__((ext_vector_type(4)));
typedef unsigned u32x2 __attribute__((ext_vector_type(2)));
typedef short bf16x8 __attribute__((ext_vector_type(8)));

constexpr int NB = 16, SEQ = 4096, CTXL = 256, DM = 1024, DEPTH = 4;
constexpr int MLAT = NB * SEQ, MCTX = NB * CTXL, MTOT = MLAT + MCTX;
constexpr int AIN = 1536, HIN = 5120, DFF = 2816, FUP = 5632;
constexpr int NTHR = 512, NWAVES = 8;
constexpr float EPS = 1e-6f;
constexpr float LOG2E = 1.4426950408889634f;

constexpr size_t MiB = 1u << 20;
constexpr size_t WS_MOD = 0;
constexpr size_t WS_LBS = 2 * MiB;
constexpr size_t WS_ROPE = 2 * MiB + 65536;
constexpr size_t WS_ROWSS = 2 * MiB + 262144;
constexpr size_t WS_XB2 = 656 * MiB;
constexpr size_t WS_D1 = 800 * MiB;
constexpr size_t WS_BIAS = 980 * MiB;
constexpr size_t WS_BAR = 3 * MiB;
constexpr size_t WS_WAIN = 4 * MiB;
constexpr size_t WS_WAOUT = 10 * MiB;
constexpr size_t WS_WHIN = 14 * MiB;
constexpr size_t WS_WHOUT = 34 * MiB;
constexpr size_t WS_WUP = 38 * MiB;
constexpr size_t WS_WDN = 82 * MiB;
constexpr size_t WS_CTXS = 104 * MiB;
constexpr size_t WS_H = 120 * MiB;
constexpr size_t WS_PROJ = 256 * MiB;
constexpr size_t WS_EDGE = 960 * MiB;
constexpr size_t WS_END = 1000 * MiB;
constexpr int LDS_BYTES = 147456;

__device__ __forceinline__ float bflo(unsigned w) { return __uint_as_float(w << 16); }
__device__ __forceinline__ float bfhi(unsigned w) { return __uint_as_float(w & 0xffff0000u); }
typedef __bf16 bf16v2_t __attribute__((ext_vector_type(2)));
__device__ __forceinline__ unsigned cvt_pk_bf16(float lo, float hi) { bf16v2_t v; v[0] = (__bf16)lo; v[1] = (__bf16)hi; return __builtin_bit_cast(unsigned, v); }
__device__ __forceinline__ float fast_rcp(float x) { return __builtin_amdgcn_rcpf(x); }
__device__ __forceinline__ float silu_f(float x) { return x * fast_rcp(1.0f + __expf(-x)); }

#define XB_TMO      128
#define XB_XCNT(j)  (256  + 64 * (j))
#define XB_XSUB(j)  (1280 + 64 * (j))
#define XB_XGEN(j)  (2304 + 64 * (j))
#define XB_TOP      3328
#define XB_TOPGEN   3392
#define XCD_BAR_WORDS 3456
#define XB_SPIN_CAP (1u << 18)

__device__ __forceinline__ unsigned xb_ld(unsigned* p)              { return __hip_atomic_load(p, __ATOMIC_RELAXED, __HIP_MEMORY_SCOPE_AGENT); }
__device__ __forceinline__ unsigned xb_add(unsigned* p, unsigned v) { return __hip_atomic_fetch_add(p, v, __ATOMIC_RELAXED, __HIP_MEMORY_SCOPE_AGENT); }
__device__ __forceinline__ unsigned xb_xcc_id() { return (unsigned)__builtin_amdgcn_s_getreg((3 << 11) | 20) & 0xFu; }
#define XB_SPIN(cond, bar) do { unsigned _sp = 0; while (cond) { __builtin_amdgcn_s_sleep(1); \
    if ((++_sp & 255u) == 0u) { if (xb_ld(&(bar)[XB_TMO])) break; if (_sp > XB_SPIN_CAP) { atomicAdd(&(bar)[XB_TMO], 1u); break; } } } } while (0)

struct XcdBarrier {
    unsigned* bar; unsigned x;
    volatile LAS unsigned* st;
};

__device__ __forceinline__ XcdBarrier xcd_barrier_post(unsigned* bar, volatile LAS unsigned* st) {
    XcdBarrier b; b.bar = bar; b.x = xb_xcc_id(); b.st = st;
    if (threadIdx.x == 0) (void)xb_add(&bar[XB_XCNT(b.x)], 1u);
    return b;
}
__device__ __forceinline__ void xcd_barrier_complete(unsigned* bar, unsigned x, unsigned& nloc, unsigned& nx) {
    const unsigned G = gridDim.x * gridDim.y * gridDim.z;
    unsigned sum, cnt, mine, sp = 0u;
    for (;;) {
        sum = 0u; cnt = 0u; mine = 0u;
#pragma unroll
        for (unsigned j = 0; j < 16; ++j) { const unsigned c = xb_ld(&bar[XB_XCNT(j)]); sum += c; cnt += (c > 0u) ? 1u : 0u; mine = (j == x) ? c : mine; }
        if (sum == G) break;
        __builtin_amdgcn_s_sleep(1);
        if ((++sp & 255u) == 0u) { if (xb_ld(&bar[XB_TMO])) break; if (sp > XB_SPIN_CAP) { atomicAdd(&bar[XB_TMO], 1u); break; } }
    }
    nloc = mine > 0u ? mine : 1u; nx = cnt > 0u ? cnt : 1u;
}

__device__ __forceinline__ void xcd_barrier(const XcdBarrier& b) {
    asm volatile("s_waitcnt vmcnt(0)" ::: "memory");
    __syncthreads();
    if (threadIdx.x == 0) {
        unsigned* bar = b.bar;
        __builtin_amdgcn_s_waitcnt(0);
        unsigned nloc = b.st[0], nx = b.st[1];
        if (nloc == 0u) { xcd_barrier_complete(bar, b.x, nloc, nx); b.st[0] = nloc; b.st[1] = nx; }
        const unsigned old = xb_add(&bar[XB_XSUB(b.x)], 1u);
        const unsigned gen = old / nloc;
        if (old + 1u == (gen + 1u) * nloc) {
            __builtin_amdgcn_fence(__ATOMIC_RELEASE, "agent");
            asm volatile("s_waitcnt vmcnt(0)" ::: "memory");
            const unsigned og = xb_add(&bar[XB_TOP], 1u);
            const unsigned tg = og / nx;
            if (og + 1u == (tg + 1u) * nx) xb_add(&bar[XB_TOPGEN], 1u);
            else XB_SPIN(xb_ld(&bar[XB_TOPGEN]) == tg, bar);
            __builtin_amdgcn_fence(__ATOMIC_ACQUIRE, "agent");
            xb_add(&bar[XB_XGEN(b.x)], 1u);
            asm volatile("s_waitcnt vmcnt(0)" ::: "memory");
        } else {
            XB_SPIN(xb_ld(&bar[XB_XGEN(b.x)]) == gen, bar);
            __builtin_amdgcn_fence(__ATOMIC_ACQUIRE, "agent");
            asm volatile("s_waitcnt vmcnt(0)" ::: "memory");
        }
    }
    __syncthreads();
}

struct EpiAct {
    static constexpr bool PERM = true, AFTER_DRAIN = false;
    bf16* O; int ldc; int mode; const float* lb; const float* rowss; const float* bias;
    __device__ __forceinline__ void operator()(const pg8::f32x4 (&acc)[2][2][4][2], const pg8::Unit& u, int wr, int wc, int fr, int fq) const {
        const int row0 = u.pm * 256 + wr * 64 + fr; const int col0 = u.pn * 256 + wc * 32 + 8 * fq;
        int act = 0;
        if (mode == 1) { const int rng = u.pn >> 2; act = (rng == 0 || rng == 4) ? 1 : (rng == 3 ? 0 : 2); }
        const float* bp = bias + (size_t)(u.pm >= 256 ? 16 : (u.pm >> 4)) * FUP + col0;
        float rsv[2][4];
#pragma unroll
        for (int ai = 0; ai < 2; ++ai)
#pragma unroll
            for (int m = 0; m < 4; ++m) rsv[ai][m] = rowss[row0 + ai * 128 + m * 16];
#pragma unroll
        for (int ai = 0; ai < 2; ++ai)
#pragma unroll
            for (int m = 0; m < 4; ++m) rsv[ai][m] = rsqrtf(rsv[ai][m] * (1.0f / DM) + EPS);
        f32x4 lbv[2][2], bv[2][2];
#pragma unroll
        for (int bj = 0; bj < 2; ++bj)
#pragma unroll
            for (int n = 0; n < 2; ++n) {
                bv[bj][n] = *(const f32x4*)(bp + bj * 128 + 4 * n);
                if (act == 2) { const f32x4 t = *(const f32x4*)(lb + ((col0 + bj * 128) & 1023) + 4 * n); lbv[bj][n] = (f32x4){1.f - t[0], 1.f - t[1], 1.f - t[2], 1.f - t[3]}; }
                else lbv[bj][n] = (f32x4){0.f, 0.f, 0.f, 0.f};
            }
#pragma unroll
        for (int ai = 0; ai < 2; ++ai)
#pragma unroll
            for (int m = 0; m < 4; ++m) {
                bf16* rowp = O + (size_t)(row0 + ai * 128 + m * 16) * ldc + col0;
                const float rs = rsv[ai][m];
#pragma unroll
                for (int bj = 0; bj < 2; ++bj) {
                    f32x4 v0 = acc[ai][bj][m][0] * rs + bv[bj][0], v1 = acc[ai][bj][m][1] * rs + bv[bj][1];
                    if (act == 1) {
#pragma unroll
                        for (int e = 0; e < 4; ++e) { v0[e] = silu_f(v0[e]); v1[e] = silu_f(v1[e]); }
                    } else if (act == 2) {
#pragma unroll
                        for (int e = 0; e < 4; ++e) { v0[e] = lbv[bj][0][e] * fast_rcp(1.0f + __expf(v0[e])); v1[e] = lbv[bj][1][e] * fast_rcp(1.0f + __expf(v1[e])); }
                    }
                    u32x4 w; w.x = cvt_pk_bf16(v0[0], v0[1]); w.y = cvt_pk_bf16(v0[2], v0[3]); w.z = cvt_pk_bf16(v1[0], v1[1]); w.w = cvt_pk_bf16(v1[2], v1[3]);
                    *(u32x4*)(rowp + bj * 128) = w;
                }
            }
    }
};
template <int DMODE> struct EpiRes {
    static constexpr bool PERM = true, AFTER_DRAIN = false;
    const float* xin_lat; const float* xin_ctx; float* xout_lat; float* xout_ctx; const float* modg;
    bf16* xb; float* rowss_next; const float* gain_n; const float* modn; int has_next;
    bf16* d1; static constexpr int dmode = DMODE;
    __device__ __forceinline__ void operator()(const pg8::f32x4 (&acc)[2][2][4][2], const pg8::Unit& u, int wr, int wc, int fr, int fq) const {
        const bool isctx = u.pm >= 256;
        const int prow0 = (isctx ? (u.pm - 256) : u.pm) * 256;
        const float* xin = isctx ? xin_ctx : xin_lat; float* xout = isctx ? xout_ctx : xout_lat;
        const int brow = isctx ? 16 : (u.pm >> 4);
        const float* gp = modg + (size_t)brow * 6144;
        const int col0 = u.pn * 256 + wc * 32 + 8 * fq;
        f32x4 gv[2][2], gm[2][2];
#pragma unroll
        for (int bj = 0; bj < 2; ++bj)
#pragma unroll
            for (int n = 0; n < 2; ++n) {
                gv[bj][n] = *(const f32x4*)(gp + col0 + bj * 128 + 4 * n);
                if (has_next) { const f32x4 g_ = *(const f32x4*)(gain_n + col0 + bj * 128 + 4 * n), s_ = *(const f32x4*)(modn + (size_t)brow * 6144 + col0 + bj * 128 + 4 * n); gm[bj][n] = g_ * (1.0f + s_); }
                else gm[bj][n] = (f32x4){0.f, 0.f, 0.f, 0.f};
            }
#pragma unroll
        for (int it = 0; it < 8; ++it) {
            const int ai = it >> 2, m = it & 3;
            const int rl = ai * 128 + wr * 64 + m * 16 + fr;
            const size_t off = (size_t)(prow0 + rl) * DM + col0;
            f32x4 cur[2][2];
#pragma unroll
            for (int bj = 0; bj < 2; ++bj) { cur[bj][0] = *(const f32x4*)(xin + off + bj * 128); cur[bj][1] = *(const f32x4*)(xin + off + bj * 128 + 4); }
            float ss = 0.f;
#pragma unroll
            for (int bj = 0; bj < 2; ++bj) {
                f32x4 dl0 = gv[bj][0] * acc[ai][bj][m][0], dl1 = gv[bj][1] * acc[ai][bj][m][1];
                bf16* dp = d1 + (size_t)(u.pm * 256 + rl) * DM + col0 + bj * 128;
                if (dmode == 2) {
                    const u32x4 dw = *(const u32x4*)dp;
                    dl0 += (f32x4){bflo(dw[0]), bfhi(dw[0]), bflo(dw[1]), bfhi(dw[1])}; dl1 += (f32x4){bflo(dw[2]), bfhi(dw[2]), bflo(dw[3]), bfhi(dw[3])};
                }
                const f32x4 x0 = cur[bj][0] + dl0, x1 = cur[bj][1] + dl1;
                if (dmode == 1) { u32x4 dw; dw.x = cvt_pk_bf16(dl0[0], dl0[1]); dw.y = cvt_pk_bf16(dl0[2], dl0[3]); dw.z = cvt_pk_bf16(dl1[0], dl1[1]); dw.w = cvt_pk_bf16(dl1[2], dl1[3]); *(u32x4*)dp = dw; }
                else { *(f32x4*)(xout + off + bj * 128) = x0; *(f32x4*)(xout + off + bj * 128 + 4) = x1; }
                if (has_next) {
                    ss += (x0[0] * x0[0] + x0[1] * x0[1]) + (x0[2] * x0[2] + x0[3] * x0[3]) + (x1[0] * x1[0] + x1[1] * x1[1]) + (x1[2] * x1[2] + x1[3] * x1[3]);
                    const f32x4 y0 = x0 * gm[bj][0], y1 = x1 * gm[bj][1];
                    u32x4 w; w.x = cvt_pk_bf16(y0[0], y0[1]); w.y = cvt_pk_bf16(y0[2], y0[3]); w.z = cvt_pk_bf16(y1[0], y1[1]); w.w = cvt_pk_bf16(y1[2], y1[3]);
                    *(u32x4*)(xb + (size_t)(u.pm * 256 + rl) * DM + col0 + bj * 128) = w;
                }
            }
            if (has_next) {
                ss += __shfl_xor(ss, 16); ss += __shfl_xor(ss, 32);
                if (fq == 0) atomicAdd(rowss_next + u.pm * 256 + rl, ss);
            }
        }
    }
};


__device__ __forceinline__ float dpp_ror1(float v)  { return __builtin_bit_cast(float, __builtin_amdgcn_update_dpp(0, __builtin_bit_cast(int, v), 0x121, 0xf, 0xf, false)); }
__device__ __forceinline__ float dpp_ror15(float v) { return __builtin_bit_cast(float, __builtin_amdgcn_update_dpp(0, __builtin_bit_cast(int, v), 0x12F, 0xf, 0xf, false)); }
struct EpiGLU {
    static constexpr bool PERM = true, AFTER_DRAIN = false;
    bf16* U; float* edge; const float* cw; const float* cb; LAS float* xg; const float* rowss; const float* bias;
    __device__ __forceinline__ void operator()(const pg8::f32x4 (&acc)[2][2][4][2], const pg8::Unit& u, int wr, int wc, int fr, int fq) const {
        const int lf = wc * 32 + 8 * fq, f0 = u.pn * 128 + lf;
        const float* bpg = bias + (size_t)(u.pm >= 256 ? 16 : (u.pm >> 4)) * FUP + u.pn * 256 + lf;
        const float* rsp = rowss + u.pm * 256 + wr * 64 + fr;
        float rsv[2][4];
#pragma unroll
        for (int ai = 0; ai < 2; ++ai)
#pragma unroll
            for (int m = 0; m < 4; ++m) rsv[ai][m] = rsp[ai * 128 + m * 16];
#pragma unroll
        for (int ai = 0; ai < 2; ++ai)
#pragma unroll
            for (int m = 0; m < 4; ++m) rsv[ai][m] = rsqrtf(rsv[ai][m] * (1.0f / DM) + EPS);
#define GLU_RS(ai_, m_) rsv[ai_][m_]
        {
            const f32x4 bg0 = *(const f32x4*)bpg, bg1 = *(const f32x4*)(bpg + 4);
#pragma unroll
            for (int ai = 0; ai < 2; ++ai) {
                const int gi = 2 * ai + wr;
                if (fr == 0)  { const float r_ = GLU_RS(ai, 0); *(LAS f32x4*)(xg + (gi * 2 + 0) * 128 + lf) = acc[ai][0][0][0] * r_ + bg0; *(LAS f32x4*)(xg + (gi * 2 + 0) * 128 + lf + 4) = acc[ai][0][0][1] * r_ + bg1; }
                if (fr == 15) { const float r_ = GLU_RS(ai, 3); *(LAS f32x4*)(xg + (gi * 2 + 1) * 128 + lf) = acc[ai][0][3][0] * r_ + bg0; *(LAS f32x4*)(xg + (gi * 2 + 1) * 128 + lf + 4) = acc[ai][0][3][1] * r_ + bg1; }
            }
            if (wr == 0 && fr < 2) {
                const float r_ = GLU_RS(0, 0);
                float* e = edge + ((size_t)u.pm * 6 + fr) * DFF + f0; *(f32x4*)e = acc[0][0][0][0] * r_ + bg0; *(f32x4*)(e + 4) = acc[0][0][0][1] * r_ + bg1;
                if (fr == 0) { const f32x4 bv0 = *(const f32x4*)(bpg + 128), bv1 = *(const f32x4*)(bpg + 132); float* ev = edge + ((size_t)u.pm * 6 + 4) * DFF + f0; *(f32x4*)ev = acc[0][1][0][0] * r_ + bv0; *(f32x4*)(ev + 4) = acc[0][1][0][1] * r_ + bv1; }
            }
            if (wr == 1 && fr >= 14) {
                const float r_ = GLU_RS(1, 3);
                float* e = edge + ((size_t)u.pm * 6 + 2 + (fr - 14)) * DFF + f0; *(f32x4*)e = acc[1][0][3][0] * r_ + bg0; *(f32x4*)(e + 4) = acc[1][0][3][1] * r_ + bg1;
                if (fr == 15) { const f32x4 bv0 = *(const f32x4*)(bpg + 128), bv1 = *(const f32x4*)(bpg + 132); float* ev = edge + ((size_t)u.pm * 6 + 5) * DFF + f0; *(f32x4*)ev = acc[1][1][3][0] * r_ + bv0; *(f32x4*)(ev + 4) = acc[1][1][3][1] * r_ + bv1; }
            }
        }
        asm volatile("s_waitcnt lgkmcnt(0)" ::: "memory"); __builtin_amdgcn_s_barrier(); asm volatile("" ::: "memory");
#pragma unroll
        for (int ai = 0; ai < 2; ++ai) {
            const int gi = 2 * ai + wr, giu = gi > 0 ? gi - 1 : 0, gid = gi < 3 ? gi + 1 : 3;
            float rs[4];
#pragma unroll
            for (int m = 0; m < 4; ++m) rs[m] = GLU_RS(ai, m);
#pragma unroll
            for (int n = 0; n < 2; ++n) {
                const f32x4 bgn = *(const f32x4*)(bpg + 4 * n), bvn = *(const f32x4*)(bpg + 128 + 4 * n);
                const f32x4 w0 = *(const f32x4*)(cw + f0 + 4 * n), w1 = *(const f32x4*)(cw + DFF + f0 + 4 * n), w2 = *(const f32x4*)(cw + 2 * DFF + f0 + 4 * n), bb = *(const f32x4*)(cb + f0 + 4 * n);
                const f32x4 xu = *(const LAS f32x4*)(xg + (giu * 2 + 1) * 128 + lf + 4 * n), xd = *(const LAS f32x4*)(xg + (gid * 2 + 0) * 128 + lf + 4 * n);
                float uv[4][4];
#pragma unroll
                for (int e = 0; e < 4; ++e) {
                    float gg[4], ur[4], dr[4];
#pragma unroll
                    for (int m = 0; m < 4; ++m) { gg[m] = acc[ai][0][m][n][e] * rs[m] + bgn[e]; ur[m] = dpp_ror1(gg[m]); dr[m] = dpp_ror15(gg[m]); }
#pragma unroll
                    for (int m = 0; m < 4; ++m) {
                        const float up = (fr == 0) ? (m > 0 ? ur[m > 0 ? m - 1 : 0] : xu[e]) : ur[m];
                        const float dn = (fr == 15) ? (m < 3 ? dr[m < 3 ? m + 1 : 3] : xd[e]) : dr[m];
                        const float c = w0[e] * up + w1[e] * gg[m] + w2[e] * dn + bb[e];
                        uv[m][e] = silu_f(c) * (acc[ai][1][m][n][e] * rs[m] + bvn[e]);
                    }
                }
#pragma unroll
                for (int m = 0; m < 4; ++m) {
                    u32x2 w; w.x = cvt_pk_bf16(uv[m][0], uv[m][1]); w.y = cvt_pk_bf16(uv[m][2], uv[m][3]);
                    *(u32x2*)(U + (size_t)(u.pm * 256 + ai * 128 + wr * 64 + m * 16 + fr) * DFF + f0 + 4 * n) = w;
                }
            }
        }
#undef GLU_RS
    }
};

struct Args {
    const float* in[21];
    float* out;
    unsigned char* ws;
};

__device__ __forceinline__ void transpose_item(const float* W, int K, int N, bf16* WT, LAS float* scr, int item, int lane, bool glu) {
    const int nblk = N / 32, kb = item / nblk, nb = item % nblk, k0 = 64 * kb, n0 = 32 * nb;
#pragma unroll 8
    for (int i = 0; i < 32; ++i) { const int kk = 2 * i + (lane >> 5); scr[kk * 33 + (lane & 31)] = W[(size_t)(k0 + kk) * N + n0 + (lane & 31)]; }
    asm volatile("s_waitcnt lgkmcnt(0)" ::: "memory");
    const int c = lane & 7;
    const int r0 = !glu ? n0 : (n0 < DFF ? (n0 >> 7) * 256 + (n0 & 127) : ((n0 - DFF) >> 7) * 256 + 128 + ((n0 - DFF) & 127));
#pragma unroll
    for (int j = 0; j < 4; ++j) { const int n = (lane >> 3) + 8 * j; const LAS float* s = scr + (8 * c) * 33 + n;
        u32x4 o; o.x = cvt_pk_bf16(s[0 * 33], s[1 * 33]); o.y = cvt_pk_bf16(s[2 * 33], s[3 * 33]); o.z = cvt_pk_bf16(s[4 * 33], s[5 * 33]); o.w = cvt_pk_bf16(s[6 * 33], s[7 * 33]);
        *(u32x4*)(WT + (size_t)(r0 + n) * K + k0 + 8 * c) = o; }
    asm volatile("s_waitcnt lgkmcnt(0)" ::: "memory");
}

__device__ __forceinline__ void prologue_phase(LAS unsigned char* lds, const Args& a, int G, int bid) {
    const int tid = opaque_tid(), lane = tid & 63, wave = tid >> 6;
    unsigned char* ws = a.ws;
    {
        LAS float* scr = (LAS float*)(lds + wave * 16384);
        const int gw = bid * NWAVES + wave, NGW = G * NWAVES;
        for (int mi = 0; mi < 16; ++mi) {
            const float* src; bf16* dst; int K, N;
            if (mi < 2)       { const int j = mi;      K = DM;  N = AIN; src = a.in[8]  + (size_t)j * DM * AIN;  dst = (bf16*)(ws + WS_WAIN)  + (size_t)j * AIN * DM; }
            else if (mi < 4)  { const int j = mi - 2;  K = DM;  N = DM;  src = a.in[9]  + (size_t)j * DM * DM;   dst = (bf16*)(ws + WS_WAOUT) + (size_t)j * DM * DM; }
            else if (mi < 6)  { const int j = mi - 4;  K = DM;  N = HIN; src = a.in[13] + (size_t)j * DM * HIN;  dst = (bf16*)(ws + WS_WHIN)  + (size_t)j * HIN * DM; }
            else if (mi < 8)  { const int j = mi - 6;  K = DM;  N = DM;  src = a.in[14] + (size_t)j * DM * DM;   dst = (bf16*)(ws + WS_WHOUT) + (size_t)j * DM * DM; }
            else if (mi < 12) { const int j = mi - 8;  K = DM;  N = FUP; src = a.in[17] + (size_t)j * DM * FUP;  dst = (bf16*)(ws + WS_WUP)   + (size_t)j * FUP * DM; }
            else              { const int j = mi - 12; K = DFF; N = DM;  src = a.in[20] + (size_t)j * DFF * DM;  dst = (bf16*)(ws + WS_WDN)   + (size_t)j * DM * DFF; }
            const int nitems = (K / 64) * (N / 32);
            for (int it = gw; it < nitems; it += NGW) transpose_item(src, K, N, dst, scr, it, lane, mi >= 8 && mi < 12);
        }
    }
    {
        const int gt = bid * NTHR + tid;
        if (gt < 1024) {
            const float* lg = a.in[16];
            const float l0 = lg[gt], l1 = lg[1024 + gt], l2 = lg[2048 + gt], l3 = lg[3072 + gt];
            const float mx = fmaxf(fmaxf(l0, l1), fmaxf(l2, l3));
            const float e0 = expf(l0 - mx), e1 = expf(l1 - mx), e2 = expf(l2 - mx), e3 = expf(l3 - mx);
            const float inv = 1.0f / (e0 + e1 + e2 + e3);
            float* lbs = (float*)(ws + WS_LBS);
            lbs[gt] = 0.f; lbs[1024 + gt] = e1 * inv; lbs[2048 + gt] = (e1 + e2) * inv; lbs[3072 + gt] = (e1 + e2 + e3) * inv;
        } else if (gt < 2048) {
            const int idx = gt - 1024, pos = idx >> 4, i = idx & 15;
            const float inv = powf(10000.0f, -(float)i / 16.0f);
            const float ang = (float)pos * inv;
            float* rp = (float*)(ws + WS_ROPE);
            rp[2 * idx] = cosf(ang); rp[2 * idx + 1] = sinf(ang);
        }
    }
    __syncthreads();
    {
        LAS float* sc = (LAS float*)lds;
        LAS float* red = (LAS float*)(lds + 81920);
        for (int e = tid; e < 17 * 1024; e += NTHR) {
            const int i = e >> 10, k = e & 1023;
            const float v = (i < 16) ? a.in[1][i * 1024 + k] : a.in[3][k];
            sc[k * 20 + i] = v / (1.0f + expf(-v));
        }
        __syncthreads();
        float* MOD = (float*)(ws + WS_MOD);
        for (int item = bid; item < 4 * 96; item += G) {
            const int l = item / 96, n0 = (item % 96) * 64;
            const float* W = a.in[4] + (size_t)l * DM * 6144 + n0 + lane;
            float accv[17];
#pragma unroll
            for (int i = 0; i < 17; ++i) accv[i] = 0.f;
            const int kbeg = wave * 128;
#pragma unroll 4
            for (int kk = 0; kk < 128; ++kk) {
                const int k = kbeg + kk;
                const float w = W[(size_t)k * 6144];
                const LAS float* s = sc + k * 20;
                const f32x4 s0 = *(const LAS f32x4*)(s), s1 = *(const LAS f32x4*)(s + 4), s2 = *(const LAS f32x4*)(s + 8), s3 = *(const LAS f32x4*)(s + 12);
                const float s16 = s[16];
#pragma unroll
                for (int e = 0; e < 4; ++e) { accv[e] += s0[e] * w; accv[4 + e] += s1[e] * w; accv[8 + e] += s2[e] * w; accv[12 + e] += s3[e] * w; }
                accv[16] += s16 * w;
            }
#pragma unroll
            for (int i = 0; i < 17; ++i) red[(wave * 17 + i) * 64 + lane] = accv[i];
            __syncthreads();
            for (int o = tid; o < 17 * 64; o += NTHR) {
                const int i = o >> 6, c = o & 63;
                float s = 0.f;
#pragma unroll
                for (int w = 0; w < 8; ++w) s += red[(w * 17 + i) * 64 + c];
                MOD[((size_t)l * 17 + i) * 6144 + n0 + c] = s + a.in[5][l * 6144 + n0 + c];
            }
            __syncthreads();
        }
    }
}

__device__ __forceinline__ void init_phase(const float* xlat, const float* xctx, const float* gain, const float* modl, bf16* XB, float* rowss, int G, int bid) {
    const int tid = opaque_tid(), lane = tid & 63, wave = tid >> 6;
    const int gw = bid * NWAVES + wave, NGW = G * NWAVES;
    f32x4 gn[4];
#pragma unroll
    for (int j = 0; j < 4; ++j) gn[j] = *((const f32x4*)gain + lane + 64 * j);
    for (int row = gw; row < MTOT; row += NGW) {
        const bool isctx = row >= MLAT;
        const float* xr = isctx ? xctx + (size_t)(row - MLAT) * DM : xlat + (size_t)row * DM;
        const float* mr = modl + (size_t)(isctx ? 16 : (row >> 12)) * 6144 + 1024;
        f32x4 v[4]; float s = 0.f;
#pragma unroll
        for (int j = 0; j < 4; ++j) { v[j] = *((const f32x4*)xr + lane + 64 * j); s += (v[j][0] * v[j][0] + v[j][1] * v[j][1]) + (v[j][2] * v[j][2] + v[j][3] * v[j][3]); }
#pragma unroll
        for (int o = 1; o < 64; o <<= 1) s += __shfl_xor(s, o);
        if (lane == 0) rowss[row] = s;
        unsigned long long* o8 = (unsigned long long*)(XB + (size_t)row * DM) + lane;
#pragma unroll
        for (int j = 0; j < 4; ++j) {
            const f32x4 sc = *((const f32x4*)mr + lane + 64 * j);
            f32x4 y;
#pragma unroll
            for (int e = 0; e < 4; ++e) y[e] = v[j][e] * gn[j][e] * (1.0f + sc[e]);
            o8[64 * j] = (unsigned long long)cvt_pk_bf16(y[0], y[1]) | ((unsigned long long)cvt_pk_bf16(y[2], y[3]) << 32);
        }
    }
}
__device__ __forceinline__ void bias_phase(LAS unsigned char* lds, const float* MOD, const unsigned char* ws, float* BIAS, int G, int bid) {
    const int tid = opaque_tid(), lane = tid & 63, wave = tid >> 6;
    LAS float* sh = (LAS float*)lds;
    LAS float* red = (LAS float*)(lds + 81920);
    int cur_inst = -1;
    for (int item = bid; item < 560; item += G) {
        int inst, n0;
        {
            int r = item; inst = 0;
#pragma unroll 1
            for (;;) { const int cnt = (inst & 1) ? 88 : (((inst >> 1) & 1) ? 80 : 24); if (r < cnt) break; r -= cnt; ++inst; }
            n0 = r * 64;
        }
        const int layer = inst >> 1, half = inst & 1, j = layer >> 1;
        const int N = half ? FUP : ((layer & 1) ? HIN : AIN);
        const bf16* WT = half ? (const bf16*)(ws + WS_WUP) + (size_t)layer * FUP * DM : ((layer & 1) ? (const bf16*)(ws + WS_WHIN) + (size_t)j * HIN * DM : (const bf16*)(ws + WS_WAIN) + (size_t)j * AIN * DM);
        if (inst != cur_inst) {
            __syncthreads();
            const float* mp = MOD + (size_t)layer * 17 * 6144 + (half ? 3 : 0) * 1024;
            for (int e = tid; e < 17 * 1024; e += NTHR) { const int i = e >> 10, k = e & 1023; sh[k * 20 + i] = mp[(size_t)i * 6144 + k]; }
            cur_inst = inst;
            __syncthreads();
        }
        float accv[17];
#pragma unroll
        for (int i = 0; i < 17; ++i) accv[i] = 0.f;
        const bf16* wr_ = WT + (size_t)(n0 + lane) * DM + wave * 128;
#pragma unroll 2
        for (int kk = 0; kk < 128; kk += 8) {
            const u32x4 w = *(const u32x4*)(wr_ + kk);
            float wf[8];
#pragma unroll
            for (int q = 0; q < 4; ++q) { wf[2 * q] = bflo(w[q]); wf[2 * q + 1] = bfhi(w[q]); }
#pragma unroll
            for (int q = 0; q < 8; ++q) {
                const LAS float* sp = sh + (wave * 128 + kk + q) * 20;
                const f32x4 s0 = *(const LAS f32x4*)sp, s1 = *(const LAS f32x4*)(sp + 4), s2 = *(const LAS f32x4*)(sp + 8), s3 = *(const LAS f32x4*)(sp + 12);
                const float s16 = sp[16];
#pragma unroll
                for (int e = 0; e < 4; ++e) { accv[e] += s0[e] * wf[q]; accv[4 + e] += s1[e] * wf[q]; accv[8 + e] += s2[e] * wf[q]; accv[12 + e] += s3[e] * wf[q]; }
                accv[16] += s16 * wf[q];
            }
        }
#pragma unroll
        for (int i = 0; i < 17; ++i) red[(wave * 17 + i) * 64 + lane] = accv[i];
        __syncthreads();
        for (int o = tid; o < 17 * 64; o += NTHR) {
            const int i = o >> 6, c = o & 63;
            float sum = 0.f;
#pragma unroll
            for (int w = 0; w < 8; ++w) sum += red[(w * 17 + i) * 64 + c];
            BIAS[((size_t)inst * 17 + i) * FUP + n0 + c] = sum;
        }
        __syncthreads();
    }
}

__device__ __forceinline__ void kprep_phase(LAS unsigned char* lds, bf16* qkv, const float* kgain, const float* ropetab, int G, int bid) {
    const int tid = opaque_tid();
    LAS f32x2* rope = (LAS f32x2*)lds;
    for (int i = tid; i < 1024; i += NTHR) rope[i] = ((const f32x2*)ropetab)[i];
    const int c = tid & 7;
    float gk[8];
#pragma unroll
    for (int e = 0; e < 8; ++e) gk[e] = kgain[c * 8 + e];
    __syncthreads();
    for (int item = (bid * NTHR + tid) >> 3; item < MTOT * 4; item += (G * NTHR) >> 3) {
        const int row = item >> 2, kh = item & 3;
        bf16* kp = qkv + (size_t)row * AIN + 1024 + kh * 64 + c * 8;
        const u32x4 r = *(const u32x4*)kp;
        float y[8];
#pragma unroll
        for (int w = 0; w < 4; ++w) { y[2 * w] = bflo(r[w]); y[2 * w + 1] = bfhi(r[w]); }
        float ss = 0.f;
#pragma unroll
        for (int e = 0; e < 8; ++e) ss += y[e] * y[e];
        ss += __shfl_xor(ss, 1); ss += __shfl_xor(ss, 2); ss += __shfl_xor(ss, 4);
        const float rs = rsqrtf(ss * (1.0f / 64.0f) + EPS);
#pragma unroll
        for (int e = 0; e < 8; ++e) y[e] = y[e] * rs * gk[e];
        if (row < MLAT) {
            const int t = row & (SEQ - 1), p = (c < 4) ? (t >> 6) : (t & 63);
#pragma unroll
            for (int e = 0; e < 8; ++e) {
                const f32x2 cs = rope[p * 16 + (c & 1) * 8 + e];
                const float own = y[e], oth = __shfl_xor(own, 2);
                y[e] = (c & 2) ? (oth * cs[1] + own * cs[0]) : (own * cs[0] - oth * cs[1]);
            }
        }
        u32x4 w; w.x = cvt_pk_bf16(y[0], y[1]); w.y = cvt_pk_bf16(y[2], y[3]); w.z = cvt_pk_bf16(y[4], y[5]); w.w = cvt_pk_bf16(y[6], y[7]);
        *(u32x4*)kp = w;
    }
    __syncthreads();
}

__device__ __forceinline__ void attn_phase(LAS unsigned char* lds, bf16* qkv, const float* qgain, const float* kgain, const float* sink, const float* ropetab, int G, int bid) {
    const int tid = opaque_tid(), lane = tid & 63, wave = tid >> 6, fr = lane & 15, fq = lane >> 4;
    LAS unsigned char* Ks = lds;
    LAS unsigned char* Vt = lds + 18432;
    LAS f32x2* rope = (LAS f32x2*)(lds + 36864);
    for (int i = tid; i < 1024; i += NTHR) rope[i] = ((const f32x2*)ropetab)[i];
    float mq = 0.f, mk = 0.f;
    for (int d = 0; d < 64; ++d) { mq = fmaxf(mq, fabsf(qgain[d])); mk = fmaxf(mk, fabsf(kgain[d])); }
    const float Mshift = 8.0f * mq * mk * LOG2E;
    __syncthreads();
    const int g = wave >> 1, whalf = wave & 1;
    for (int u = bid; u < 34 * 64; u += G) {
        const int qb = u >> 6, rem = u & 63, b = rem >> 2, kh = rem & 3;
        const bool qctx = qb >= 32;
        const int hq = kh * 4 + g;
        const int qrow0 = qctx ? (MLAT + b * CTXL + (qb - 32) * 128 + whalf * 64) : (b * SEQ + qb * 128 + whalf * 64);
        bf16x8 qf[4][2];
        float gq[16];
#pragma unroll
        for (int e = 0; e < 8; ++e) { gq[e] = qgain[fq * 8 + e]; gq[8 + e] = qgain[32 + fq * 8 + e]; }
#pragma unroll
        for (int qi = 0; qi < 4; ++qi) {
            const bf16* qp = qkv + (size_t)(qrow0 + qi * 16 + fr) * AIN + hq * 64 + fq * 8;
            const u32x4 r0 = *(const u32x4*)qp, r1 = *(const u32x4*)(qp + 32);
            float y[16];
#pragma unroll
            for (int w = 0; w < 4; ++w) { y[2 * w] = bflo(r0[w]); y[2 * w + 1] = bfhi(r0[w]); y[8 + 2 * w] = bflo(r1[w]); y[8 + 2 * w + 1] = bfhi(r1[w]); }
            float ss = 0.f;
#pragma unroll
            for (int e = 0; e < 16; ++e) ss += y[e] * y[e];
            ss += __shfl_xor(ss, 16); ss += __shfl_xor(ss, 32);
            const float rs = rsqrtf(ss * (1.0f / 64.0f) + EPS);
#pragma unroll
            for (int e = 0; e < 16; ++e) y[e] = y[e] * rs * gq[e];
            if (!qctx) {
                const int t = qb * 128 + whalf * 64 + qi * 16 + fr, prow = t >> 6, pcol = t & 63;
#pragma unroll
                for (int dh = 0; dh < 2; ++dh)
#pragma unroll
                    for (int e = 0; e < 8; ++e) {
                        const f32x2 cs = rope[(dh ? pcol : prow) * 16 + (fq & 1) * 8 + e];
                        const float own = y[dh * 8 + e], oth = __shfl_xor(own, 32);
                        y[dh * 8 + e] = (fq & 2) ? (oth * cs[1] + own * cs[0]) : (own * cs[0] - oth * cs[1]);
                    }
            }
            const float QS = 0.125f * LOG2E;
#pragma unroll
            for (int dh = 0; dh < 2; ++dh) {
                u32x4 w;
                w.x = cvt_pk_bf16(y[dh * 8 + 0] * QS, y[dh * 8 + 1] * QS); w.y = cvt_pk_bf16(y[dh * 8 + 2] * QS, y[dh * 8 + 3] * QS);
                w.z = cvt_pk_bf16(y[dh * 8 + 4] * QS, y[dh * 8 + 5] * QS); w.w = cvt_pk_bf16(y[dh * 8 + 6] * QS, y[dh * 8 + 7] * QS);
                qf[qi][dh] = __builtin_bit_cast(bf16x8, w);
            }
        }
        f32x4 o[4][4];
#pragma unroll
        for (int dt = 0; dt < 4; ++dt)
#pragma unroll
            for (int qi = 0; qi < 4; ++qi) o[dt][qi] = (f32x4){0.f, 0.f, 0.f, 0.f};
        float lsum[4] = {0.f, 0.f, 0.f, 0.f};
#define ATT_VALID(s_) ((s_) >= 3 ? true : (!qctx && (qb - 1 + (s_)) >= 0 && (qb - 1 + (s_)) <= 31))
#define ATT_KROW(s_) ((s_) >= 3 ? (MLAT + b * CTXL + ((s_) - 3) * 128) : (b * SEQ + (qb - 1 + (s_)) * 128))
#define ATT_FETCH(s_) do { const int kr_ = ATT_KROW(s_); \
            const bf16* kp_ = qkv + (size_t)(kr_ + (tid >> 3)) * AIN + 1024 + kh * 64 + (tid & 7) * 8; \
            pk0 = *(const u32x4*)kp_; pk1 = *(const u32x4*)(kp_ + (size_t)64 * AIN); \
            const bf16* vp_ = qkv + (size_t)(kr_ + 2 * (tid >> 3)) * AIN + 1280 + kh * 64 + (tid & 7) * 8; \
            pv0 = *(const u32x4*)vp_; pv1 = *(const u32x4*)(vp_ + AIN); } while (0)
        u32x4 pk0, pk1, pv0, pv1;
        int sb = 0;
        while (sb < 5 && !ATT_VALID(sb)) ++sb;
        ATT_FETCH(sb);
        while (sb < 5) {
            const int type = sb < 3 ? sb : 3;
            asm volatile("s_waitcnt lgkmcnt(0)" ::: "memory"); __builtin_amdgcn_s_barrier(); asm volatile("" ::: "memory");
            {
                const int key = tid >> 3, c = tid & 7;
                *(LAS u32x4*)(Ks + key * 144 + c * 16) = pk0;
                *(LAS u32x4*)(Ks + (key + 64) * 144 + c * 16) = pk1;
                const int kp = tid >> 3;
#pragma unroll
                for (int w = 0; w < 4; ++w) {
                    const unsigned lo = (pv0[w] & 0xffffu) | (pv1[w] << 16), hi = (pv0[w] >> 16) | (pv1[w] & 0xffff0000u);
                    *(LAS unsigned*)(Vt + (c * 8 + 2 * w) * 288 + kp * 4) = lo;
                    *(LAS unsigned*)(Vt + (c * 8 + 2 * w + 1) * 288 + kp * 4) = hi;
                }
            }
            int nsb = sb + 1;
            while (nsb < 5 && !ATT_VALID(nsb)) ++nsb;
            if (nsb < 5) ATT_FETCH(nsb);
            asm volatile("s_waitcnt lgkmcnt(0)" ::: "memory"); __builtin_amdgcn_s_barrier(); asm volatile("" ::: "memory");
#pragma unroll 1
            for (int T = 0; T < 4; ++T) {
                bf16x8 kf[2][2];
#pragma unroll
                for (int sub = 0; sub < 2; ++sub)
#pragma unroll
                    for (int dh = 0; dh < 2; ++dh) kf[sub][dh] = *(const LAS bf16x8*)(Ks + (T * 32 + sub * 16 + fr) * 144 + dh * 64 + fq * 16);
                bf16x8 pb[4];
#pragma unroll
                for (int qi = 0; qi < 4; ++qi) {
                    f32x4 s0 = (f32x4){0.f, 0.f, 0.f, 0.f}, s1 = (f32x4){0.f, 0.f, 0.f, 0.f};
                    s0 = __builtin_amdgcn_mfma_f32_16x16x32_bf16(kf[0][0], qf[qi][0], s0, 0, 0, 0);
                    s0 = __builtin_amdgcn_mfma_f32_16x16x32_bf16(kf[0][1], qf[qi][1], s0, 0, 0, 0);
                    s1 = __builtin_amdgcn_mfma_f32_16x16x32_bf16(kf[1][0], qf[qi][0], s1, 0, 0, 0);
                    s1 = __builtin_amdgcn_mfma_f32_16x16x32_bf16(kf[1][1], qf[qi][1], s1, 0, 0, 0);
                    const int qq = whalf * 64 + qi * 16 + fr;
                    float p0[4], p1[4];
#pragma unroll
                    for (int j = 0; j < 4; ++j) {
                        const int k0 = T * 32 + fq * 4 + j, k1 = k0 + 16;
                        bool v0 = true, v1 = true;
                        if (type == 0) { v0 = k0 >= qq; v1 = k1 >= qq; }
                        else if (type == 2) { v0 = k0 <= qq; v1 = k1 <= qq; }
                        p0[j] = v0 ? __builtin_amdgcn_exp2f(s0[j] - Mshift) : 0.f;
                        p1[j] = v1 ? __builtin_amdgcn_exp2f(s1[j] - Mshift) : 0.f;
                    }
                    lsum[qi] += (p0[0] + p0[1]) + (p0[2] + p0[3]) + (p1[0] + p1[1]) + (p1[2] + p1[3]);
                    u32x4 w; w.x = cvt_pk_bf16(p0[0], p0[1]); w.y = cvt_pk_bf16(p0[2], p0[3]); w.z = cvt_pk_bf16(p1[0], p1[1]); w.w = cvt_pk_bf16(p1[2], p1[3]);
                    pb[qi] = __builtin_bit_cast(bf16x8, w);
                }
#pragma unroll
                for (int dt = 0; dt < 4; ++dt) {
                    const LAS unsigned char* vp = Vt + (dt * 16 + fr) * 288 + (T * 32 + fq * 4) * 2;
                    const u32x2 lo = *(const LAS u32x2*)vp, hi = *(const LAS u32x2*)(vp + 32);
                    u32x4 w; w.x = lo[0]; w.y = lo[1]; w.z = hi[0]; w.w = hi[1];
                    const bf16x8 vf = __builtin_bit_cast(bf16x8, w);
#pragma unroll
                    for (int qi = 0; qi < 4; ++qi) o[dt][qi] = __builtin_amdgcn_mfma_f32_16x16x32_bf16(vf, pb[qi], o[dt][qi], 0, 0, 0);
                }
            }
            sb = nsb;
        }
#undef ATT_VALID
#undef ATT_KROW
#undef ATT_FETCH
        const float sk = __builtin_amdgcn_exp2f(sink[hq] * LOG2E - Mshift);
#pragma unroll
        for (int qi = 0; qi < 4; ++qi) {
            float l = lsum[qi];
            l += __shfl_xor(l, 16); l += __shfl_xor(l, 32);
            const float inv = 1.0f / (l + sk);
            bf16* op = qkv + (size_t)(qrow0 + qi * 16 + fr) * AIN + hq * 64 + fq * 4;
#pragma unroll
            for (int dt = 0; dt < 4; ++dt) {
                const f32x4 v = o[dt][qi];
                u32x2 w; w.x = cvt_pk_bf16(v[0] * inv, v[1] * inv); w.y = cvt_pk_bf16(v[2] * inv, v[3] * inv);
                *(u32x2*)(op + dt * 16) = w;
            }
        }
    }
    __syncthreads();
}

__device__ __forceinline__ int scan_row16(int b, int dir, int c, int t) {
    if (c < 16) { const int p = c * 16 + t; return MLAT + b * CTXL + (dir ? (CTXL - 1 - p) : p); }
    const int p = (c - 16) * 16 + t; return b * SEQ + (dir ? (SEQ - 1 - p) : p);
}
__device__ __forceinline__ void scan_phase(LAS unsigned char* lds, bf16* proj, int G, int bid) {
    const int tid = opaque_tid(), lane = tid & 63, wave = tid >> 6, fr = lane & 15, fq = lane >> 4;
    constexpr int KRS = 132;
    constexpr int SET = 34304, O_KR = 0, O_QR = 8448, O_QE = 16896, O_KE = 21248, O_KD = 25600, O_DV = 33792, O_VT = 2 * SET, QST = 272;
    const int st = tid >> 4, sc8 = tid & 15;
    const int pdk = tid >> 2, ptq = tid & 3;
    const bool stager = tid < 256;
#define SC_LOAD(c_) do { const bf16* rp_ = proj + (size_t)scan_row16(b, dir, (c_), st) * HIN + h * 128 + sc8 * 8; \
        rq = *(const u32x4*)rp_; rk = *(const u32x4*)(rp_ + kcol - h * 128); rv = *(const u32x4*)(rp_ + 3072); } while (0)
#define SC_WRITE(c_) do { LAS float* kd_ = (LAS float*)(lds + ((c_) & 1) * SET + O_KR) + st * KRS + sc8 * 8; LAS float* qd_ = (LAS float*)(lds + ((c_) & 1) * SET + O_QR) + st * KRS + sc8 * 8; \
        LAS unsigned short* vd_ = (LAS unsigned short*)(lds + O_VT + ((c_) % 3) * 8192) + (sc8 * 8) * 32 + (st >> 2) * 8 + (st & 3); \
        _Pragma("unroll") for (int w_ = 0; w_ < 4; ++w_) { kd_[2 * w_] = bflo(rk[w_]); kd_[2 * w_ + 1] = bfhi(rk[w_]); qd_[2 * w_] = bflo(rq[w_]); qd_[2 * w_ + 1] = bfhi(rq[w_]); \
            vd_[(2 * w_) * 32] = (unsigned short)(rv[w_] & 0xffffu); vd_[(2 * w_ + 1) * 32] = (unsigned short)(rv[w_] >> 16); } } while (0)
    for (int chain = bid; chain < 256; chain += G) {
        const int b = chain >> 4, h = (chain >> 1) & 7, dir = chain & 1;
        const int kcol = 1024 + dir * 1024 + h * 128;
        f32x4 S[8];
#pragma unroll
        for (int i = 0; i < 8; ++i) S[i] = (f32x4){0.f, 0.f, 0.f, 0.f};
        u32x4 rk = (u32x4){0u, 0u, 0u, 0u}, rq = rk, rv = rk;
#define SC_QUAD(v_, ctrl_) __builtin_bit_cast(float, __builtin_amdgcn_update_dpp(0, __builtin_bit_cast(int, (v_)), (ctrl_), 0xf, 0xf, false))
#define SC_PREP(cp_) do { LAS unsigned char* pset_ = lds + ((cp_) & 1) * SET; \
            const LAS float* kr_ = (const LAS float*)(pset_ + O_KR) + (ptq * 4) * KRS + pdk; \
            const LAS float* qr_ = (const LAS float*)(pset_ + O_QR) + (ptq * 4) * KRS + pdk; \
            float kk_[4], qq_[4], ff_[4]; \
            _Pragma("unroll") for (int i_ = 0; i_ < 4; ++i_) { kk_[i_] = kr_[i_ * KRS]; qq_[i_] = qr_[i_ * KRS]; } \
            ff_[0] = fmaxf(1.0f - kk_[0], 0.0067f); \
            _Pragma("unroll") for (int i_ = 1; i_ < 4; ++i_) ff_[i_] = ff_[i_ - 1] * fmaxf(1.0f - kk_[i_], 0.0067f);        \
              \
            float inc_ = ff_[3]; \
            { const float s1_ = SC_QUAD(inc_, 0x90); inc_ = (ptq >= 1) ? inc_ * s1_ : inc_; }        \
            { const float s2_ = SC_QUAD(inc_, 0x40); inc_ = (ptq >= 2) ? inc_ * s2_ : inc_; }        \
            const float prev_ = SC_QUAD(inc_, 0x90); const float exc_ = (ptq >= 1) ? prev_ : 1.0f;     \
            const float bs_ = SC_QUAD(inc_, 0xFF);                                                    \
            LAS unsigned short* qe_ = (LAS unsigned short*)(pset_ + O_QE) + (ptq * 4) * (QST / 2) + pdk; \
            LAS unsigned short* ke_ = (LAS unsigned short*)(pset_ + O_KE) + (ptq * 4) * (QST / 2) + pdk; \
            float kd_[4]; \
            _Pragma("unroll") for (int i_ = 0; i_ < 4; ++i_) { const float F_ = exc_ * ff_[i_]; const float inv_ = fast_rcp(F_); const float qv_ = qq_[i_] * F_, kev_ = kk_[i_] * inv_; kd_[i_] = kev_ * bs_; \
                const unsigned pk_ = cvt_pk_bf16(qv_, kev_); qe_[i_ * (QST / 2)] = (unsigned short)(pk_ & 0xffffu); ke_[i_ * (QST / 2)] = (unsigned short)(pk_ >> 16); } \
            u32x2 kw_; kw_.x = cvt_pk_bf16(kd_[0], kd_[1]); kw_.y = cvt_pk_bf16(kd_[2], kd_[3]); \
            *(LAS u32x2*)(pset_ + O_KD + pdk * 64 + ptq * 16) = kw_; \
            if (ptq == 0) ((LAS float*)(pset_ + O_DV))[pdk] = bs_; } while (0)
        __syncthreads();
        {
            const u32x4 z4 = (u32x4){0u, 0u, 0u, 0u};
            for (int o_ = tid * 16; o_ < 8192; o_ += NTHR * 16) { *(LAS u32x4*)(lds + O_KD + o_) = z4; *(LAS u32x4*)(lds + SET + O_KD + o_) = z4; *(LAS u32x4*)(lds + O_VT + o_) = z4; *(LAS u32x4*)(lds + O_VT + 8192 + o_) = z4; *(LAS u32x4*)(lds + O_VT + 16384 + o_) = z4; }
        }
        if (stager) SC_LOAD(0);
        __syncthreads();
        if (stager) { SC_WRITE(0); SC_LOAD(1); }
        __syncthreads();
        SC_PREP(0);
        if (stager) { SC_WRITE(1); SC_LOAD(2); }
        __syncthreads();
#pragma unroll 1
        for (int c = 0; c < 272; ++c) {
            LAS unsigned char* set = lds + (c & 1) * SET;
            SC_PREP(c + 1);
            {
                const LAS unsigned char* qeb = set + O_QE + fr * QST; const LAS unsigned char* keb = set + O_KE + fr * QST;
                bf16x8 kaf[4], qbf[4];
#pragma unroll
                for (int i = 0; i < 4; ++i) { kaf[i] = *(const LAS bf16x8*)(keb + (32 * i + fq * 8) * 2); qbf[i] = *(const LAS bf16x8*)(qeb + (32 * i + fq * 8) * 2); }
                u32x2 qlo[4], qhi[4];
#pragma unroll
                for (int i = 0; i < 4; ++i) { qlo[i] = *(const LAS u32x2*)(qeb + (32 * i + fq * 4) * 2); qhi[i] = *(const LAS u32x2*)(qeb + (32 * i + 16 + fq * 4) * 2); }
                const bf16x8 vf = *(const LAS bf16x8*)(lds + O_VT + (c % 3) * 8192 + (wave * 16 + fr) * 64 + fq * 16);
                f32x4 pt = (f32x4){0.f, 0.f, 0.f, 0.f};
#pragma unroll
                for (int i = 0; i < 4; ++i) pt = __builtin_amdgcn_mfma_f32_16x16x32_bf16(kaf[i], qbf[i], pt, 0, 0, 0);
                f32x4 oacc = (f32x4){0.f, 0.f, 0.f, 0.f};
#pragma unroll
                for (int i = 0; i < 4; ++i) {
                    u32x4 sw; sw.x = cvt_pk_bf16(S[2 * i][0], S[2 * i][1]); sw.y = cvt_pk_bf16(S[2 * i][2], S[2 * i][3]); sw.z = cvt_pk_bf16(S[2 * i + 1][0], S[2 * i + 1][1]); sw.w = cvt_pk_bf16(S[2 * i + 1][2], S[2 * i + 1][3]);
                    u32x4 qw; qw.x = qlo[i][0]; qw.y = qlo[i][1]; qw.z = qhi[i][0]; qw.w = qhi[i][1];
                    oacc = __builtin_amdgcn_mfma_f32_16x16x32_bf16(__builtin_bit_cast(bf16x8, sw), __builtin_bit_cast(bf16x8, qw), oacc, 0, 0, 0);
                }
                const LAS float* dv = (const LAS float*)(set + O_DV);
#pragma unroll
                for (int kt = 0; kt < 8; ++kt) {
                    const f32x4 d4 = *(const LAS f32x4*)(dv + kt * 16 + fq * 4);
                    const bf16x8 ka = *(const LAS bf16x8*)(set + O_KD + (kt * 16 + fr) * 64 + fq * 16);
                    S[kt] = __builtin_amdgcn_mfma_f32_16x16x32_bf16(ka, vf, S[kt] * d4, 0, 0, 0);
                }
#pragma unroll
                for (int j = 0; j < 4; ++j) pt[j] = (fq * 4 + j <= fr) ? pt[j] : 0.f;
                u32x4 pw; pw.x = cvt_pk_bf16(pt[0], pt[1]); pw.y = cvt_pk_bf16(pt[2], pt[3]); pw.z = 0u; pw.w = 0u;
                oacc = __builtin_amdgcn_mfma_f32_16x16x32_bf16(vf, __builtin_bit_cast(bf16x8, pw), oacc, 0, 0, 0);
                {
                    u32x2 ow; ow.x = cvt_pk_bf16(oacc[0], oacc[1]); ow.y = cvt_pk_bf16(oacc[2], oacc[3]);
                    *(u32x2*)(proj + (size_t)scan_row16(b, dir, c, fr) * HIN + kcol + wave * 16 + fq * 4) = ow;
                }
            }
            if (stager) { if (c + 2 < 272) SC_WRITE(c + 2); if (c + 3 < 272) SC_LOAD(c + 3); }
            asm volatile("s_waitcnt lgkmcnt(0)" ::: "memory"); __builtin_amdgcn_s_barrier(); asm volatile("" ::: "memory");
        }
        __syncthreads();
    }
#undef SC_PREP
#undef SC_QUAD
#undef SC_LOAD
#undef SC_WRITE
}
__device__ __forceinline__ void readout_phase(const bf16* proj, const float* ogain, bf16* H, int nrows, int G, int bid) {
    const int tid = opaque_tid(), lane = tid & 63, wave = tid >> 6;
    const int gw = bid * NWAVES + wave, NGW = G * NWAVES;
    float gn[16];
#pragma unroll
    for (int e = 0; e < 16; ++e) gn[e] = ogain[(lane & 7) * 16 + e];
    for (int row = gw; row < nrows; row += NGW) {
        const bf16* rp = proj + (size_t)row * HIN + lane * 16;
        float o[16], gt[16];
#pragma unroll
        for (int hh = 0; hh < 2; ++hh) {
            const u32x4 f = *(const u32x4*)(rp + 1024 + hh * 8), bw = *(const u32x4*)(rp + 2048 + hh * 8), gg = *(const u32x4*)(rp + 4096 + hh * 8);
#pragma unroll
            for (int w = 0; w < 4; ++w) {
                o[hh * 8 + 2 * w] = bflo(f[w]) + bflo(bw[w]); o[hh * 8 + 2 * w + 1] = bfhi(f[w]) + bfhi(bw[w]);
                gt[hh * 8 + 2 * w] = bflo(gg[w]); gt[hh * 8 + 2 * w + 1] = bfhi(gg[w]);
            }
        }
        float ss = 0.f;
#pragma unroll
        for (int e = 0; e < 16; ++e) ss += o[e] * o[e];
        ss += __shfl_xor(ss, 1); ss += __shfl_xor(ss, 2); ss += __shfl_xor(ss, 4);
        const float rs = rsqrtf(ss * (1.0f / 128.0f) + EPS);
        u32x4 w0, w1;
#define RO(e) (o[e] * rs * gn[e] * gt[e])
        w0.x = cvt_pk_bf16(RO(0), RO(1)); w0.y = cvt_pk_bf16(RO(2), RO(3)); w0.z = cvt_pk_bf16(RO(4), RO(5)); w0.w = cvt_pk_bf16(RO(6), RO(7));
        w1.x = cvt_pk_bf16(RO(8), RO(9)); w1.y = cvt_pk_bf16(RO(10), RO(11)); w1.z = cvt_pk_bf16(RO(12), RO(13)); w1.w = cvt_pk_bf16(RO(14), RO(15));
#undef RO
        bf16* hp = H + (size_t)row * DM + lane * 16;
        *(u32x4*)hp = w0; *(u32x4*)(hp + 8) = w1;
    }
}

__device__ __forceinline__ void glu_fix_phase(bf16* U, const float* edge, const float* cw, const float* cb, int ntiles, int G, int bid) {
    const int tid = opaque_tid();
    const int nitems = ntiles * 2 * (DFF / 4);
    for (int item = bid * NTHR + tid; item < nitems; item += G * NTHR) {
        const int f = (item % (DFF / 4)) * 4, te = item / (DFF / 4), pm = te >> 1, bot = te & 1;
        const bool isctx = pm >= 256;
        const bool first = isctx || (pm & 15) == 0, lastt = isctx || (pm & 15) == 15;
        const float* eb = edge + (size_t)pm * 6 * DFF + f;
        const f32x4 z = (f32x4){0.f, 0.f, 0.f, 0.f};
        f32x4 up, cur, dn, vl;
        if (!bot) { up = first ? z : *(const f32x4*)(eb - 3 * DFF); cur = *(const f32x4*)eb; dn = *(const f32x4*)(eb + DFF); vl = *(const f32x4*)(eb + 4 * DFF); }
        else      { up = *(const f32x4*)(eb + 2 * DFF); cur = *(const f32x4*)(eb + 3 * DFF); dn = lastt ? z : *(const f32x4*)(eb + 6 * DFF); vl = *(const f32x4*)(eb + 5 * DFF); }
        const f32x4 a0 = *(const f32x4*)(cw + f), a1 = *(const f32x4*)(cw + DFF + f), a2 = *(const f32x4*)(cw + 2 * DFF + f), bb = *(const f32x4*)(cb + f);
        float o[4];
#pragma unroll
        for (int e = 0; e < 4; ++e) o[e] = silu_f(a0[e] * up[e] + a1[e] * cur[e] + a2[e] * dn[e] + bb[e]) * vl[e];
        u32x2 w; w.x = cvt_pk_bf16(o[0], o[1]); w.y = cvt_pk_bf16(o[2], o[3]);
        *(u32x2*)(U + (size_t)(pm * 256 + (bot ? 255 : 0)) * DFF + f) = w;
    }
}

__global__ void __launch_bounds__(NTHR, 2) fwd_kernel(Args a) {
    extern __shared__ __attribute__((aligned(16))) unsigned char lds_raw[];
    LAS unsigned char* lds = (LAS unsigned char*)lds_raw;
    cg::grid_group grid = cg::this_grid();
    {
        if (threadIdx.x < 32) ((LAS unsigned*)(lds + 135168))[threadIdx.x] = 0u;
        __syncthreads();
    }
    const XcdBarrier xbar = xcd_barrier_post((unsigned*)(a.ws + WS_BAR), (volatile LAS unsigned*)(lds + 135168));
#define GRID_SYNC() xcd_barrier(xbar)
    const int G = gridDim.x, bid = blockIdx.x;
    unsigned char* ws = a.ws;
    float* MOD = (float*)(ws + WS_MOD);
    const float* LBS = (const float*)(ws + WS_LBS);
    const float* ROPE = (const float*)(ws + WS_ROPE);
    float* CTXS = (float*)(ws + WS_CTXS);
    bf16* H = (bf16*)(ws + WS_H);
    bf16* PROJ = (bf16*)(ws + WS_PROJ);
    float* EDGE = (float*)(ws + WS_EDGE);
    float* ROWSS = (float*)(ws + WS_ROWSS);
    float* BIAS = (float*)(ws + WS_BIAS);
    bf16* XB2 = (bf16*)(ws + WS_XB2);

#ifndef NO_PRO
    prologue_phase(lds, a, G, bid);
#endif
    grid.sync();
    bias_phase(lds, MOD, ws, BIAS, G, bid);
    init_phase(a.in[0], a.in[2], a.in[6], MOD, H, ROWSS, G, bid);
    GRID_SYNC();

#pragma unroll 1
    for (int layer = 0; layer < DEPTH; ++layer) {
        const bool last = layer == DEPTH - 1;
        const bool is_attn = (layer & 1) == 0;
        const int j = layer >> 1;
        const float* modl = MOD + (size_t)layer * 17 * 6144;
#pragma unroll 1
        for (int half = 0; half < 2; ++half) {
            const bool first = (layer == 0 && half == 0);
            const bool xorig = (layer == 0);
            const float* xin_lat = xorig ? a.in[0] : a.out;
            const float* xin_ctx = xorig ? a.in[2] : CTXS;
            const int nrows_x = (last && half == 1) ? MLAT : MTOT;
            const int nrows_o = last ? MLAT : MTOT;
            const int inst = layer * 2 + half;
            {
                float* z = ROWSS + ((inst + 1) & 1) * MTOT;
                for (int i = bid * NTHR + opaque_tid(); i < MTOT; i += G * NTHR) z[i] = 0.f;
            }
            const bf16* A1 = (half == 1 && !is_attn) ? XB2 : H;
            {
                pg8::Gemm g; int ldc, mode;
                if (half == 0) {
                    if (is_attn) { g = pg8::Gemm{A1, (const bf16*)(ws + WS_WAIN) + (size_t)j * AIN * DM, MTOT, AIN, DM, DM}; ldc = AIN; mode = 0; }
                    else         { g = pg8::Gemm{A1, (const bf16*)(ws + WS_WHIN) + (size_t)j * HIN * DM, MTOT, HIN, DM, DM}; ldc = HIN; mode = 1; }
                } else           { g = pg8::Gemm{A1, (const bf16*)(ws + WS_WUP) + (size_t)layer * FUP * DM, nrows_x, FUP, DM, DM}; ldc = FUP; mode = 0; }
                pg8::StaticOrder S; S.init(g.M, g.N, G, bid);
                if (half == 0) {
                    EpiAct E{PROJ, ldc, mode, LBS + layer * 1024, ROWSS + (inst & 1) * MTOT, BIAS + (size_t)inst * 17 * FUP};
                    pg8::gemm_phase<EpiAct, pg8::StaticOrder, true, true>(lds, g, S, E);
                } else {
                    EpiGLU E{PROJ, EDGE, a.in[18] + (size_t)layer * 3 * DFF, a.in[19] + (size_t)layer * DFF, (LAS float*)(lds + 131072), ROWSS + (inst & 1) * MTOT, BIAS + (size_t)inst * 17 * FUP};
                    pg8::gemm_phase<EpiGLU, pg8::StaticOrder, true, true>(lds, g, S, E);
                }
            }
            GRID_SYNC();
            if (half == 0) {
                if (is_attn) {
                    kprep_phase(lds, PROJ, a.in[11] + j * 64, ROPE, G, bid);
                    GRID_SYNC();
#ifndef NO_ATTN
                    attn_phase(lds, PROJ, a.in[10] + j * 64, a.in[11] + j * 64, a.in[12] + j * 16, ROPE, G, bid);
#endif
                } else {
#ifndef NO_SCAN
                    scan_phase(lds, PROJ, G, bid);
#endif
                    GRID_SYNC();
#ifndef NO_RO
                    readout_phase(PROJ, a.in[15] + j * 128, H, nrows_o, G, bid);
#endif
                }
            } else {
                glu_fix_phase(PROJ, EDGE, a.in[18] + (size_t)layer * 3 * DFF, a.in[19] + (size_t)layer * DFF, nrows_o / 256, G, bid);
            }
            GRID_SYNC();
            {
                pg8::Gemm g;
                if (half == 0) {
                    if (is_attn) g = pg8::Gemm{PROJ, (const bf16*)(ws + WS_WAOUT) + (size_t)j * DM * DM, nrows_o, DM, DM, AIN};
                    else         g = pg8::Gemm{H, (const bf16*)(ws + WS_WHOUT) + (size_t)j * DM * DM, nrows_o, DM, DM, DM};
                } else           g = pg8::Gemm{PROJ, (const bf16*)(ws + WS_WDN) + (size_t)layer * DM * DFF, nrows_o, DM, DFF, DFF};
                pg8::StaticOrder S; S.init(g.M, g.N, G, bid);
                const int has_next = inst < 2 * DEPTH - 1;
                const int ln = half ? (has_next ? layer + 1 : layer) : layer;
                float* rsn = ROWSS + ((inst + 1) & 1) * MTOT; const float* gnn = (half ? a.in[6] : a.in[7]) + ln * DM; const float* mdn = MOD + (size_t)ln * 17 * 6144 + (half ? 1 : 4) * 1024;
                if (half == 0) {
                    EpiRes<1> E{xin_lat, xin_ctx, a.out, CTXS, modl + 2 * 1024, is_attn ? H : XB2, rsn, gnn, mdn, has_next, (bf16*)(ws + WS_D1)};
                    pg8::gemm_phase<EpiRes<1>, pg8::StaticOrder, true, true>(lds, g, S, E);
                } else {
                    EpiRes<2> E{xin_lat, xin_ctx, a.out, CTXS, modl + 5 * 1024, H, rsn, gnn, mdn, has_next, (bf16*)(ws + WS_D1)};
                    pg8::gemm_phase<EpiRes<2>, pg8::StaticOrder, true, true>(lds, g, S, E);
                }
            }
            GRID_SYNC();
        }
    }
}

extern "C" void kernel_launch(void* const* d_in, const int* in_sizes, int n_in, void* d_out, int out_size, void* d_ws, size_t ws_size, hipStream_t stream) {
    static int grid = 0;
    if (grid == 0) {
        if (n_in != 21 || ws_size < WS_END) { fprintf(stderr, "kernel_launch: unexpected inputs (n_in %d, ws %zu, need %zu)\n", n_in, ws_size, (size_t)WS_END); grid = -1; return; }
        int dev = 0, cus = 0, per_cu = 0;
        hipGetDevice(&dev);
        hipDeviceGetAttribute(&cus, hipDeviceAttributeMultiprocessorCount, dev);
        if (hipFuncSetAttribute((const void*)fwd_kernel, hipFuncAttributeMaxDynamicSharedMemorySize, LDS_BYTES) != hipSuccess) { fprintf(stderr, "kernel_launch: hipFuncSetAttribute failed\n"); grid = -1; return; }
        if (hipOccupancyMaxActiveBlocksPerMultiprocessor(&per_cu, (const void*)fwd_kernel, NTHR, LDS_BYTES) != hipSuccess || per_cu < 1) { fprintf(stderr, "kernel_launch: occupancy query failed (%d)\n", per_cu); per_cu = 1; }
        (void)hipGetLastError();
        grid = cus * per_cu;
        fprintf(stderr, "kernel_launch: grid %d (cus %d x %d)\n", grid, cus, per_cu);
    }
    if (grid < 0) return;
    if (hipMemsetAsync((char*)d_ws + WS_BAR, 0, 16384, stream) != hipSuccess) { fprintf(stderr, "kernel_launch: memset failed\n"); return; }
    Args a{};
    for (int i = 0; i < 21; ++i) a.in[i] = (const float*)d_in[i];
    a.out = (float*)d_out; a.ws = (unsigned char*)d_ws;
    void* args[] = {&a};
    hipError_t e = hipLaunchCooperativeKernel((const void*)fwd_kernel, dim3(grid), dim3(NTHR), args, LDS_BYTES, stream);
    if (e != hipSuccess) fprintf(stderr, "kernel_launch: cooperative launch failed: %s (grid %d)\n", hipGetErrorString(e), grid);
}
```

```cpp
#include <hip/hip_runtime.h>
#include <hip/hip_cooperative_groups.h>
#include <cstdio>
#include <cstdint>
namespace cg = cooperative_groups;
__device__ __forceinline__ int opaque_tid() { int t = threadIdx.x; asm volatile("" : "+v"(t)); return t; }
namespace pg8 {
#define PG8_LAS __attribute__((address_space(3)))
typedef unsigned short bf16_t;
typedef short bf16x8 __attribute__((ext_vector_type(8)));
typedef float f32x4 __attribute__((ext_vector_type(4)));
typedef unsigned u32x4 __attribute__((ext_vector_type(4)));
constexpr int BM = 256, BK = 64, HALF = 128, HTB = HALF * BK * 2  , STAGE_BYTES = 8 * HTB, NXCD = 8, WGM = 4;

__host__ __device__ __forceinline__ int lds_byte(int r, int c) { const int st = (r >> 4) * 2 + (c >> 5), rr = r & 15, cc = c & 31, ob = rr * 64 + cc * 2; return st * 1024 + (ob ^ (((ob >> 9) & 1) << 5)); }
__host__ __device__ __forceinline__ void stage_rc(int b, int& R, int& C) { const int st = b / 1024, sb = b % 1024, swz = sb ^ (((sb >> 9) & 1) << 5); R = (st >> 1) * 16 + swz / 64; C = (st & 1) * 32 + (swz % 64) / 2; }
__host__ __device__ __forceinline__ int perm32(int rho) { const int n = rho >> 4, i = rho & 15; return 8 * (i >> 2) + 4 * n + (i & 3); }

struct Unit { int pm, pn; };
struct Gemm { const bf16_t* A; const bf16_t* Bt; int M, N, K, lda; };

struct StaticOrder {
    int nM, nN, nwg, G, c;
    __host__ __device__ void init(int M, int N, int G_, int c_) { nM = M / BM; nN = N / BM; nwg = nM * nN; G = G_; c = c_; }
    __host__ __device__ bool next(int i, Unit& u) const {
        const long L = (long)i * G + c; if (L >= nwg) return false;
        int wgid = (int)L; { const int q = nwg / NXCD, r = nwg % NXCD, xcd = wgid % NXCD, off = wgid / NXCD; wgid = (xcd < r ? xcd * (q + 1) : r * (q + 1) + (xcd - r) * q) + off; }
        const int nig = WGM * nN, gid = wgid / nig, fm = gid * WGM, gsz = (nM - fm) < WGM ? (nM - fm) : WGM;
        u.pm = fm + ((wgid % nig) % gsz); u.pn = (wgid % nig) / gsz; return true;
    }
    __device__ __forceinline__ void a_ready(const Unit&) const {}
    __device__ __forceinline__ void done(const Unit&) const {}
};

template <class Epi, class Sched, bool ALIGN_EPI = false, bool SP2 = false>
__device__ __forceinline__ void gemm_phase(PG8_LAS unsigned char* lds, const Gemm g, const Sched& S, const Epi& E) {
    const int tid = opaque_tid(), wid = __builtin_amdgcn_readfirstlane(tid >> 6), lane = tid & 63, wr = wid >> 2, wc = wid & 3, fr = lane & 15, fq = lane >> 4;
    const int K = g.K, nt = K / BK;
    unsigned voffA[2], voffB[2];
#pragma unroll
    for (int i = 0; i < 2; ++i) { int R, C; stage_rc(tid * 16 + i * 8192, R, C); const int Rb = Epi::PERM ? ((R & ~31) + perm32(R & 31)) : R;
        voffA[i] = (unsigned)(R * g.lda + C) * 2u; voffB[i] = (unsigned)(Rb * K + C) * 2u; }
    const size_t kstep = (size_t)(BK * 2);
    const size_t hstepA = (size_t)HALF * g.lda * 2, hstepB = (size_t)HALF * K * 2;
    const size_t tstepA = 2 * hstepA, tstepB = 2 * hstepB;
    const unsigned ldsw = (unsigned)wid * 1024u;
    const int aoff = lds_byte(wr * 64 + fr, fq * 8), boff = lds_byte(wc * 32 + fr, fq * 8);
#define PG8_SA(b, h) (((b) * 2 + (h)) * HTB)
#define PG8_SB(b, h) ((4 + (b) * 2 + (h)) * HTB)
#define PG8_STAGE(bufoff, gbase, voff) do { _Pragma("unroll") for (int _i = 0; _i < 2; ++_i) \
        __builtin_amdgcn_global_load_lds((const unsigned*)((const char*)(gbase) + (voff)[_i]), (PG8_LAS unsigned*)(lds + (bufoff) + ldsw + _i * 8192), 16, 0, 0); } while (0)
#define PG8_LDA(dst, b, h) do { _Pragma("unroll") for (int m = 0; m < 4; ++m) _Pragma("unroll") for (int k = 0; k < 2; ++k) dst[m][k] = *(const PG8_LAS bf16x8*)(lds + PG8_SA(b, h) + aoff + m * 2048 + k * 1024); } while (0)
#define PG8_LDB(dst, b, h) do { _Pragma("unroll") for (int n = 0; n < 2; ++n) _Pragma("unroll") for (int k = 0; k < 2; ++k) dst[n][k] = *(const PG8_LAS bf16x8*)(lds + PG8_SB(b, h) + boff + n * 2048 + k * 1024); } while (0)
#define PG8_MMA(ai, bj, At, Bt) do { __builtin_amdgcn_s_setprio(1); _Pragma("unroll") for (int m = 0; m < 4; ++m) _Pragma("unroll") for (int n = 0; n < 2; ++n) _Pragma("unroll") for (int k = 0; k < 2; ++k) \
        acc[ai][bj][m][n] = __builtin_amdgcn_mfma_f32_16x16x32_bf16(Bt[n][k], At[m][k], acc[ai][bj][m][n], 0, 0, 0); __builtin_amdgcn_s_setprio(0); } while (0)
#define PG8_WAIT_V(n) asm volatile("s_waitcnt vmcnt(" #n ")" ::: "memory")
#define PG8_WAIT_L(n) asm volatile("s_waitcnt lgkmcnt(" #n ")" ::: "memory")
#define PG8_BAR __builtin_amdgcn_s_barrier()
#define PG8_SCHED __builtin_amdgcn_sched_barrier(0)
    Unit cur, nxt; int ui = 0;
    if (!S.next(0, cur)) return;
    f32x4 acc[2][2][4][2];
#pragma unroll
    for (int a = 0; a < 2; ++a)
#pragma unroll
        for (int b = 0; b < 2; ++b)
#pragma unroll
            for (int m = 0; m < 4; ++m)
#pragma unroll
                for (int n = 0; n < 2; ++n) acc[a][b][m][n] = (f32x4){0.f, 0.f, 0.f, 0.f};
    bf16x8 At[4][2], B0[2][2], B1[2][2];
    const char* cA = (const char*)g.A + (size_t)cur.pm * tstepA; const char* cB = (const char*)g.Bt + (size_t)cur.pn * tstepB;
    S.a_ready(cur);
    if constexpr (SP2) {
        PG8_STAGE(PG8_SB(0, 0), cB, voffB); PG8_STAGE(PG8_SB(0, 1), cB + hstepB, voffB); PG8_STAGE(PG8_SA(0, 0), cA, voffA); PG8_STAGE(PG8_SA(0, 1), cA + hstepA, voffA);
        if (wr == 1) PG8_BAR;
        PG8_WAIT_V(2); PG8_BAR;
        PG8_STAGE(PG8_SB(1, 0), cB + kstep, voffB); PG8_STAGE(PG8_SA(1, 0), cA + kstep, voffA); PG8_STAGE(PG8_SB(1, 1), cB + hstepB + kstep, voffB);
        PG8_WAIT_V(6); PG8_BAR;
    } else {
        PG8_STAGE(PG8_SB(0, 0), cB, voffB); PG8_STAGE(PG8_SA(0, 0), cA, voffA); PG8_STAGE(PG8_SB(0, 1), cB + hstepB, voffB); PG8_STAGE(PG8_SA(0, 1), cA + hstepA, voffA);
        if (wr == 1) PG8_BAR;
        PG8_WAIT_V(4); PG8_BAR;
        PG8_STAGE(PG8_SB(1, 0), cB + kstep, voffB); PG8_STAGE(PG8_SA(1, 0), cA + kstep, voffA); PG8_STAGE(PG8_SB(1, 1), cB + hstepB + kstep, voffB);
        PG8_WAIT_V(6); PG8_BAR;
    }
    for (;;) {
        const bool has_next = S.next(ui + 1, nxt);
        const char* nA = has_next ? (const char*)g.A + (size_t)nxt.pm * tstepA : cA; const char* nB = has_next ? (const char*)g.Bt + (size_t)nxt.pn * tstepB : cB;
        for (int t = 0; t < nt; t += 2) {
            const bool last = (t == nt - 2);
            const char* a1 = cA + (size_t)(t + 1) * kstep;
            const char* a2 = last ? nA : cA + (size_t)(t + 2) * kstep; const char* b2 = last ? nB : cB + (size_t)(t + 2) * kstep;
            const char* a3 = a2 + kstep; const char* b3 = b2 + kstep;
            if (last && has_next) S.a_ready(nxt);
            if constexpr (SP2) {
            PG8_LDB(B0, 0, 0); PG8_LDB(B1, 0, 1); PG8_SCHED; PG8_LDA(At, 0, 0); PG8_STAGE(PG8_SA(1, 1), a1 + hstepA, voffA);
            PG8_WAIT_V(8); PG8_WAIT_L(0); PG8_BAR; PG8_MMA(0, 0, At, B0); PG8_MMA(0, 1, At, B1); PG8_BAR; PG8_SCHED;
            PG8_LDA(At, 0, 1); PG8_STAGE(PG8_SB(0, 0), b2, voffB); PG8_STAGE(PG8_SB(0, 1), b2 + hstepB, voffB); PG8_STAGE(PG8_SA(0, 0), a2, voffA);
            PG8_WAIT_V(8); PG8_WAIT_L(0); PG8_BAR; PG8_MMA(1, 0, At, B0); PG8_MMA(1, 1, At, B1); PG8_BAR; PG8_SCHED;
            PG8_LDB(B0, 1, 0); PG8_LDB(B1, 1, 1); PG8_SCHED; PG8_LDA(At, 1, 0); PG8_STAGE(PG8_SA(0, 1), a2 + hstepA, voffA);
            PG8_WAIT_V(8); PG8_WAIT_L(0); PG8_BAR; PG8_MMA(0, 0, At, B0); PG8_MMA(0, 1, At, B1); PG8_BAR; PG8_SCHED;
            PG8_LDA(At, 1, 1); PG8_STAGE(PG8_SB(1, 0), b3, voffB); PG8_STAGE(PG8_SB(1, 1), b3 + hstepB, voffB); PG8_STAGE(PG8_SA(1, 0), a3, voffA);
            PG8_WAIT_V(8); PG8_WAIT_L(0); PG8_BAR; PG8_MMA(1, 0, At, B0); PG8_MMA(1, 1, At, B1); PG8_BAR; PG8_SCHED;
            } else {
            PG8_LDB(B0, 0, 0); PG8_SCHED; PG8_LDA(At, 0, 0); PG8_STAGE(PG8_SA(1, 1), a1 + hstepA, voffA);
            PG8_WAIT_L(8); PG8_BAR; PG8_WAIT_L(0); PG8_MMA(0, 0, At, B0); PG8_BAR; PG8_SCHED;
            PG8_LDB(B1, 0, 1); PG8_STAGE(PG8_SB(0, 0), b2, voffB);
            PG8_BAR; PG8_WAIT_L(0); PG8_MMA(0, 1, At, B1); PG8_BAR;
            PG8_LDA(At, 0, 1); PG8_STAGE(PG8_SA(0, 0), a2, voffA);
            PG8_BAR; PG8_WAIT_L(0); PG8_MMA(1, 0, At, B0); PG8_BAR; PG8_SCHED;
            PG8_STAGE(PG8_SB(0, 1), b2 + hstepB, voffB);
            PG8_WAIT_V(6); PG8_BAR; PG8_MMA(1, 1, At, B1); PG8_BAR;
            PG8_LDB(B0, 1, 0); PG8_SCHED; PG8_LDA(At, 1, 0); PG8_STAGE(PG8_SA(0, 1), a2 + hstepA, voffA);
            PG8_WAIT_L(8); PG8_BAR; PG8_WAIT_L(0); PG8_MMA(0, 0, At, B0); PG8_BAR; PG8_SCHED;
            PG8_LDB(B1, 1, 1); PG8_STAGE(PG8_SB(1, 0), b3, voffB);
            PG8_BAR; PG8_WAIT_L(0); PG8_MMA(0, 1, At, B1); PG8_BAR;
            PG8_LDA(At, 1, 1); PG8_STAGE(PG8_SA(1, 0), a3, voffA);
            PG8_BAR; PG8_WAIT_L(0); PG8_MMA(1, 0, At, B0); PG8_BAR; PG8_SCHED;
            PG8_STAGE(PG8_SB(1, 1), b3 + hstepB, voffB);
            PG8_WAIT_V(6); PG8_BAR; PG8_MMA(1, 1, At, B1); PG8_BAR;
            }
        }
        if constexpr (ALIGN_EPI) { if (wr == 0) PG8_BAR; }
        if constexpr (!Epi::AFTER_DRAIN) { E(acc, cur, wr, wc, fr, fq); S.done(cur); }
        if (!has_next) break;
#pragma unroll
        for (int a = 0; a < 2; ++a)
#pragma unroll
            for (int b = 0; b < 2; ++b)
#pragma unroll
                for (int m = 0; m < 4; ++m)
#pragma unroll
                    for (int n = 0; n < 2; ++n) acc[a][b][m][n] = (f32x4){0.f, 0.f, 0.f, 0.f};
        cur = nxt; cA = nA; cB = nB; ++ui;
        if constexpr (ALIGN_EPI) { if (wr == 1) PG8_BAR; }
    }
    PG8_WAIT_V(0);
    if constexpr (!ALIGN_EPI) { if (wr == 0) PG8_BAR; }
    PG8_BAR;
    if constexpr (Epi::AFTER_DRAIN) { E.fused(acc, cur, wr, wc, fr, fq, lds, wid, lane); S.done(cur); }
#undef PG8_SA
#undef PG8_SB
#undef PG8_STAGE
#undef PG8_LDA
#undef PG8_LDB
#undef PG8_MMA
#undef PG8_WAIT_V
#undef PG8_WAIT_L
#undef PG8_BAR
#undef PG8_SCHED
}
}

#define LAS __attribute__((address_space(3)))
typedef unsigned short bf16;
typedef float f32x4 __attribute__((ext_vector_type(4)));
typedef float f32x2 __attribute__((ext_vector_type(2)));
typedef unsigned u32x4 __attribute__((ext_vector_type(4)));
typedef unsigned u32x2 __attribute__((ext_vector_type(2)));
typedef short bf16x8 __attribute__((ext_vector_type(8)));

constexpr int NB = 16, SEQ = 4096, CTXL = 256, DM = 1024, DEPTH = 4;
constexpr int MLAT = NB * SEQ, MCTX = NB * CTXL, MTOT = MLAT + MCTX;
constexpr int AIN = 1536, HIN = 5120, DFF = 2816, FUP = 5632;
constexpr int NTHR = 512, NWAVES = 8;
constexpr float EPS = 1e-6f;
constexpr float LOG2E = 1.4426950408889634f;

constexpr size_t MiB = 1u << 20;
constexpr size_t WS_MOD = 0;
constexpr size_t WS_LBS = 2 * MiB;
constexpr size_t WS_ROPE = 2 * MiB + 65536;
constexpr size_t WS_ROWSS = 2 * MiB + 262144;
constexpr size_t WS_XB2 = 656 * MiB;
constexpr size_t WS_D1 = 800 * MiB;
constexpr size_t WS_BIAS = 980 * MiB;
constexpr size_t WS_BAR = 3 * MiB;
constexpr size_t WS_WAIN = 4 * MiB;
constexpr size_t WS_WAOUT = 10 * MiB;
constexpr size_t WS_WHIN = 14 * MiB;
constexpr size_t WS_WHOUT = 34 * MiB;
constexpr size_t WS_WUP = 38 * MiB;
constexpr size_t WS_WDN = 82 * MiB;
constexpr size_t WS_CTXS = 104 * MiB;
constexpr size_t WS_H = 120 * MiB;
constexpr size_t WS_PROJ = 256 * MiB;
constexpr size_t WS_EDGE = 960 * MiB;
constexpr size_t WS_END = 1000 * MiB;
constexpr int LDS_BYTES = 147456;

__device__ __forceinline__ float bflo(unsigned w) { return __uint_as_float(w << 16); }
__device__ __forceinline__ float bfhi(unsigned w) { return __uint_as_float(w & 0xffff0000u); }
typedef __bf16 bf16v2_t __attribute__((ext_vector_type(2)));
__device__ __forceinline__ unsigned cvt_pk_bf16(float lo, float hi) { bf16v2_t v; v[0] = (__bf16)lo; v[1] = (__bf16)hi; return __builtin_bit_cast(unsigned, v); }
__device__ __forceinline__ float fast_rcp(float x) { return __builtin_amdgcn_rcpf(x); }
__device__ __forceinline__ float silu_f(float x) { return x * fast_rcp(1.0f + __expf(-x)); }

#define XB_TMO      128
#define XB_XCNT(j)  (256  + 64 * (j))
#define XB_XSUB(j)  (1280 + 64 * (j))
#define XB_XGEN(j)  (2304 + 64 * (j))
#define XB_TOP      3328
#define XB_TOPGEN   3392
#define XCD_BAR_WORDS 3456
#define XB_SPIN_CAP (1u << 18)

__device__ __forceinline__ unsigned xb_ld(unsigned* p)              { return __hip_atomic_load(p, __ATOMIC_RELAXED, __HIP_MEMORY_SCOPE_AGENT); }
__device__ __forceinline__ unsigned xb_add(unsigned* p, unsigned v) { return __hip_atomic_fetch_add(p, v, __ATOMIC_RELAXED, __HIP_MEMORY_SCOPE_AGENT); }
__device__ __forceinline__ unsigned xb_xcc_id() { return (unsigned)__builtin_amdgcn_s_getreg((3 << 11) | 20) & 0xFu; }
#define XB_SPIN(cond, bar) do { unsigned _sp = 0; while (cond) { __builtin_amdgcn_s_sleep(1); \
    if ((++_sp & 255u) == 0u) { if (xb_ld(&(bar)[XB_TMO])) break; if (_sp > XB_SPIN_CAP) { atomicAdd(&(bar)[XB_TMO], 1u); break; } } } } while (0)

struct XcdBarrier {
    unsigned* bar; unsigned x;
    volatile LAS unsigned* st;
};

__device__ __forceinline__ XcdBarrier xcd_barrier_post(unsigned* bar, volatile LAS unsigned* st) {
    XcdBarrier b; b.bar = bar; b.x = xb_xcc_id(); b.st = st;
    if (threadIdx.x == 0) (void)xb_add(&bar[XB_XCNT(b.x)], 1u);
    return b;
}
__device__ __forceinline__ void xcd_barrier_complete(unsigned* bar, unsigned x, unsigned& nloc, unsigned& nx) {
    const unsigned G = gridDim.x * gridDim.y * gridDim.z;
    unsigned sum, cnt, mine, sp = 0u;
    for (;;) {
        sum = 0u; cnt = 0u; mine = 0u;
#pragma unroll
        for (unsigned j = 0; j < 16; ++j) { const unsigned c = xb_ld(&bar[XB_XCNT(j)]); sum += c; cnt += (c > 0u) ? 1u : 0u; mine = (j == x) ? c : mine; }
        if (sum == G) break;
        __builtin_amdgcn_s_sleep(1);
        if ((++sp & 255u) == 0u) { if (xb_ld(&bar[XB_TMO])) break; if (sp > XB_SPIN_CAP) { atomicAdd(&bar[XB_TMO], 1u); break; } }
    }
    nloc = mine > 0u ? mine : 1u; nx = cnt > 0u ? cnt : 1u;
}

__device__ __forceinline__ void xcd_barrier(const XcdBarrier& b) {
    asm volatile("s_waitcnt vmcnt(0)" ::: "memory");
    __syncthreads();
    if (threadIdx.x == 0) {
        unsigned* bar = b.bar;
        __builtin_amdgcn_s_waitcnt(0);
        unsigned nloc = b.st[0], nx = b.st[1];
        if (nloc == 0u) { xcd_barrier_complete(bar, b.x, nloc, nx); b.st[0] = nloc; b.st[1] = nx; }
        const unsigned old = xb_add(&bar[XB_XSUB(b.x)], 1u);
        const unsigned gen = old / nloc;
        if (old + 1u == (gen + 1u) * nloc) {
            __builtin_amdgcn_fence(__ATOMIC_RELEASE, "agent");
            asm volatile("s_waitcnt vmcnt(0)" ::: "memory");
            const unsigned og = xb_add(&bar[XB_TOP], 1u);
            const unsigned tg = og / nx;
            if (og + 1u == (tg + 1u) * nx) xb_add(&bar[XB_TOPGEN], 1u);
            else XB_SPIN(xb_ld(&bar[XB_TOPGEN]) == tg, bar);
            __builtin_amdgcn_fence(__ATOMIC_ACQUIRE, "agent");
            xb_add(&bar[XB_XGEN(b.x)], 1u);
            asm volatile("s_waitcnt vmcnt(0)" ::: "memory");
        } else {
            XB_SPIN(xb_ld(&bar[XB_XGEN(b.x)]) == gen, bar);
            __builtin_amdgcn_fence(__ATOMIC_ACQUIRE, "agent");
            asm volatile("s_waitcnt vmcnt(0)" ::: "memory");
        }
    }
    __syncthreads();
}

struct EpiAct {
    static constexpr bool PERM = true, AFTER_DRAIN = false;
    bf16* O; int ldc; int mode; const float* lb; const float* rowss; const float* bias;
    __device__ __forceinline__ void operator()(const pg8::f32x4 (&acc)[2][2][4][2], const pg8::Unit& u, int wr, int wc, int fr, int fq) const {
        const int row0 = u.pm * 256 + wr * 64 + fr; const int col0 = u.pn * 256 + wc * 32 + 8 * fq;
        int act = 0;
        if (mode == 1) { const int rng = u.pn >> 2; act = (rng == 0 || rng == 4) ? 1 : (rng == 3 ? 0 : 2); }
        const float* bp = bias + (size_t)(u.pm >= 256 ? 16 : (u.pm >> 4)) * FUP + col0;
        float rsv[2][4];
#pragma unroll
        for (int ai = 0; ai < 2; ++ai)
#pragma unroll
            for (int m = 0; m < 4; ++m) rsv[ai][m] = rowss[row0 + ai * 128 + m * 16];
#pragma unroll
        for (int ai = 0; ai < 2; ++ai)
#pragma unroll
            for (int m = 0; m < 4; ++m) rsv[ai][m] = rsqrtf(rsv[ai][m] * (1.0f / DM) + EPS);
        f32x4 lbv[2][2], bv[2][2];
#pragma unroll
        for (int bj = 0; bj < 2; ++bj)
#pragma unroll
            for (int n = 0; n < 2; ++n) {
                bv[bj][n] = *(const f32x4*)(bp + bj * 128 + 4 * n);
                if (act == 2) { const f32x4 t = *(const f32x4*)(lb + ((col0 + bj * 128) & 1023) + 4 * n); lbv[bj][n] = (f32x4){1.f - t[0], 1.f - t[1], 1.f - t[2], 1.f - t[3]}; }
                else lbv[bj][n] = (f32x4){0.f, 0.f, 0.f, 0.f};
            }
#pragma unroll
        for (int ai = 0; ai < 2; ++ai)
#pragma unroll
            for (int m = 0; m < 4; ++m) {
                bf16* rowp = O + (size_t)(row0 + ai * 128 + m * 16) * ldc + col0;
                const float rs = rsv[ai][m];
#pragma unroll
                for (int bj = 0; bj < 2; ++bj) {
                    f32x4 v0 = acc[ai][bj][m][0] * rs + bv[bj][0], v1 = acc[ai][bj][m][1] * rs + bv[bj][1];
                    if (act == 1) {
#pragma unroll
                        for (int e = 0; e < 4; ++e) { v0[e] = silu_f(v0[e]); v1[e] = silu_f(v1[e]); }
                    } else if (act == 2) {
#pragma unroll
                        for (int e = 0; e < 4; ++e) { v0[e] = lbv[bj][0][e] * fast_rcp(1.0f + __expf(v0[e])); v1[e] = lbv[bj][1][e] * fast_rcp(1.0f + __expf(v1[e])); }
                    }
                    u32x4 w; w.x = cvt_pk_bf16(v0[0], v0[1]); w.y = cvt_pk_bf16(v0[2], v0[3]); w.z = cvt_pk_bf16(v1[0], v1[1]); w.w = cvt_pk_bf16(v1[2], v1[3]);
                    *(u32x4*)(rowp + bj * 128) = w;
                }
            }
    }
};
template <int DMODE> struct EpiRes {
    static constexpr bool PERM = true, AFTER_DRAIN = false;
    const float* xin_lat; const float* xin_ctx; float* xout_lat; float* xout_ctx; const float* modg;
    bf16* xb; float* rowss_next; const float* gain_n; const float* modn; int has_next;
    bf16* d1; static constexpr int dmode = DMODE;
    __device__ __forceinline__ void operator()(const pg8::f32x4 (&acc)[2][2][4][2], const pg8::Unit& u, int wr, int wc, int fr, int fq) const {
        const bool isctx = u.pm >= 256;
        const int prow0 = (isctx ? (u.pm - 256) : u.pm) * 256;
        const float* xin = isctx ? xin_ctx : xin_lat; float* xout = isctx ? xout_ctx : xout_lat;
        const int brow = isctx ? 16 : (u.pm >> 4);
        const float* gp = modg + (size_t)brow * 6144;
        const int col0 = u.pn * 256 + wc * 32 + 8 * fq;
        f32x4 gv[2][2], gm[2][2];
#pragma unroll
        for (int bj = 0; bj < 2; ++bj)
#pragma unroll
            for (int n = 0; n < 2; ++n) {
                gv[bj][n] = *(const f32x4*)(gp + col0 + bj * 128 + 4 * n);
                if (has_next) { const f32x4 g_ = *(const f32x4*)(gain_n + col0 + bj * 128 + 4 * n), s_ = *(const f32x4*)(modn + (size_t)brow * 6144 + col0 + bj * 128 + 4 * n); gm[bj][n] = g_ * (1.0f + s_); }
                else gm[bj][n] = (f32x4){0.f, 0.f, 0.f, 0.f};
            }
#pragma unroll
        for (int it = 0; it < 8; ++it) {
            const int ai = it >> 2, m = it & 3;
            const int rl = ai * 128 + wr * 64 + m * 16 + fr;
            const size_t off = (size_t)(prow0 + rl) * DM + col0;
            f32x4 cur[2][2];
#pragma unroll
            for (int bj = 0; bj < 2; ++bj) { cur[bj][0] = *(const f32x4*)(xin + off + bj * 128); cur[bj][1] = *(const f32x4*)(xin + off + bj * 128 + 4); }
            float ss = 0.f;
#pragma unroll
            for (int bj = 0; bj < 2; ++bj) {
                f32x4 dl0 = gv[bj][0] * acc[ai][bj][m][0], dl1 = gv[bj][1] * acc[ai][bj][m][1];
                bf16* dp = d1 + (size_t)(u.pm * 256 + rl) * DM + col0 + bj * 128;
                if (dmode == 2) {
                    const u32x4 dw = *(const u32x4*)dp;
                    dl0 += (f32x4){bflo(dw[0]), bfhi(dw[0]), bflo(dw[1]), bfhi(dw[1])}; dl1 += (f32x4){bflo(dw[2]), bfhi(dw[2]), bflo(dw[3]), bfhi(dw[3])};
                }
                const f32x4 x0 = cur[bj][0] + dl0, x1 = cur[bj][1] + dl1;
                if (dmode == 1) { u32x4 dw; dw.x = cvt_pk_bf16(dl0[0], dl0[1]); dw.y = cvt_pk_bf16(dl0[2], dl0[3]); dw.z = cvt_pk_bf16(dl1[0], dl1[1]); dw.w = cvt_pk_bf16(dl1[2], dl1[3]); *(u32x4*)dp = dw; }
                else { *(f32x4*)(xout + off + bj * 128) = x0; *(f32x4*)(xout + off + bj * 128 + 4) = x1; }
                if (has_next) {
                    ss += (x0[0] * x0[0] + x0[1] * x0[1]) + (x0[2] * x0[2] + x0[3] * x0[3]) + (x1[0] * x1[0] + x1[1] * x1[1]) + (x1[2] * x1[2] + x1[3] * x1[3]);
                    const f32x4 y0 = x0 * gm[bj][0], y1 = x1 * gm[bj][1];
                    u32x4 w; w.x = cvt_pk_bf16(y0[0], y0[1]); w.y = cvt_pk_bf16(y0[2], y0[3]); w.z = cvt_pk_bf16(y1[0], y1[1]); w.w = cvt_pk_bf16(y1[2], y1[3]);
                    *(u32x4*)(xb + (size_t)(u.pm * 256 + rl) * DM + col0 + bj * 128) = w;
                }
            }
            if (has_next) {
                ss += __shfl_xor(ss, 16); ss += __shfl_xor(ss, 32);
                if (fq == 0) atomicAdd(rowss_next + u.pm * 256 + rl, ss);
            }
        }
    }
};


__device__ __forceinline__ float dpp_ror1(float v)  { return __builtin_bit_cast(float, __builtin_amdgcn_update_dpp(0, __builtin_bit_cast(int, v), 0x121, 0xf, 0xf, false)); }
__device__ __forceinline__ float dpp_ror15(float v) { return __builtin_bit_cast(float, __builtin_amdgcn_update_dpp(0, __builtin_bit_cast(int, v), 0x12F, 0xf, 0xf, false)); }
struct EpiGLU {
    static constexpr bool PERM = true, AFTER_DRAIN = false;
    bf16* U; float* edge; const float* cw; const float* cb; LAS float* xg; const float* rowss; const float* bias;
    __device__ __forceinline__ void operator()(const pg8::f32x4 (&acc)[2][2][4][2], const pg8::Unit& u, int wr, int wc, int fr, int fq) const {
        const int lf = wc * 32 + 8 * fq, f0 = u.pn * 128 + lf;
        const float* bpg = bias + (size_t)(u.pm >= 256 ? 16 : (u.pm >> 4)) * FUP + u.pn * 256 + lf;
        const float* rsp = rowss + u.pm * 256 + wr * 64 + fr;
        float rsv[2][4];
#pragma unroll
        for (int ai = 0; ai < 2; ++ai)
#pragma unroll
            for (int m = 0; m < 4; ++m) rsv[ai][m] = rsp[ai * 128 + m * 16];
#pragma unroll
        for (int ai = 0; ai < 2; ++ai)
#pragma unroll
            for (int m = 0; m < 4; ++m) rsv[ai][m] = rsqrtf(rsv[ai][m] * (1.0f / DM) + EPS);
#define GLU_RS(ai_, m_) rsv[ai_][m_]
        {
            const f32x4 bg0 = *(const f32x4*)bpg, bg1 = *(const f32x4*)(bpg + 4);
#pragma unroll
            for (int ai = 0; ai < 2; ++ai) {
                const int gi = 2 * ai + wr;
                if (fr == 0)  { const float r_ = GLU_RS(ai, 0); *(LAS f32x4*)(xg + (gi * 2 + 0) * 128 + lf) = acc[ai][0][0][0] * r_ + bg0; *(LAS f32x4*)(xg + (gi * 2 + 0) * 128 + lf + 4) = acc[ai][0][0][1] * r_ + bg1; }
                if (fr == 15) { const float r_ = GLU_RS(ai, 3); *(LAS f32x4*)(xg + (gi * 2 + 1) * 128 + lf) = acc[ai][0][3][0] * r_ + bg0; *(LAS f32x4*)(xg + (gi * 2 + 1) * 128 + lf + 4) = acc[ai][0][3][1] * r_ + bg1; }
            }
            if (wr == 0 && fr < 2) {
                const float r_ = GLU_RS(0, 0);
                float* e = edge + ((size_t)u.pm * 6 + fr) * DFF + f0; *(f32x4*)e = acc[0][0][0][0] * r_ + bg0; *(f32x4*)(e + 4) = acc[0][0][0][1] * r_ + bg1;
                if (fr == 0) { const f32x4 bv0 = *(const f32x4*)(bpg + 128), bv1 = *(const f32x4*)(bpg + 132); float* ev = edge + ((size_t)u.pm * 6 + 4) * DFF + f0; *(f32x4*)ev = acc[0][1][0][0] * r_ + bv0; *(f32x4*)(ev + 4) = acc[0][1][0][1] * r_ + bv1; }
            }
            if (wr == 1 && fr >= 14) {
                const float r_ = GLU_RS(1, 3);
                float* e = edge + ((size_t)u.pm * 6 + 2 + (fr - 14)) * DFF + f0; *(f32x4*)e = acc[1][0][3][0] * r_ + bg0; *(f32x4*)(e + 4) = acc[1][0][3][1] * r_ + bg1;
                if (fr == 15) { const f32x4 bv0 = *(const f32x4*)(bpg + 128), bv1 = *(const f32x4*)(bpg + 132); float* ev = edge + ((size_t)u.pm * 6 + 5) * DFF + f0; *(f32x4*)ev = acc[1][1][3][0] * r_ + bv0; *(f32x4*)(ev + 4) = acc[1][1][3][1] * r_ + bv1; }
            }
        }
        asm volatile("s_waitcnt lgkmcnt(0)" ::: "memory"); __builtin_amdgcn_s_barrier(); asm volatile("" ::: "memory");
#pragma unroll
        for (int ai = 0; ai < 2; ++ai) {
            const int gi = 2 * ai + wr, giu = gi > 0 ? gi - 1 : 0, gid = gi < 3 ? gi + 1 : 3;
            float rs[4];
#pragma unroll
            for (int m = 0; m < 4; ++m) rs[m] = GLU_RS(ai, m);
#pragma unroll
            for (int n = 0; n < 2; ++n) {
                const f32x4 bgn = *(const f32x4*)(bpg + 4 * n), bvn = *(const f32x4*)(bpg + 128 + 4 * n);
                const f32x4 w0 = *(const f32x4*)(cw + f0 + 4 * n), w1 = *(const f32x4*)(cw + DFF + f0 + 4 * n), w2 = *(const f32x4*)(cw + 2 * DFF + f0 + 4 * n), bb = *(const f32x4*)(cb + f0 + 4 * n);
                const f32x4 xu = *(const LAS f32x4*)(xg + (giu * 2 + 1) * 128 + lf + 4 * n), xd = *(const LAS f32x4*)(xg + (gid * 2 + 0) * 128 + lf + 4 * n);
                float uv[4][4];
#pragma unroll
                for (int e = 0; e < 4; ++e) {
                    float gg[4], ur[4], dr[4];
#pragma unroll
                    for (int m = 0; m < 4; ++m) { gg[m] = acc[ai][0][m][n][e] * rs[m] + bgn[e]; ur[m] = dpp_ror1(gg[m]); dr[m] = dpp_ror15(gg[m]); }
#pragma unroll
                    for (int m = 0; m < 4; ++m) {
                        const float up = (fr == 0) ? (m > 0 ? ur[m > 0 ? m - 1 : 0] : xu[e]) : ur[m];
                        const float dn = (fr == 15) ? (m < 3 ? dr[m < 3 ? m + 1 : 3] : xd[e]) : dr[m];
                        const float c = w0[e] * up + w1[e] * gg[m] + w2[e] * dn + bb[e];
                        uv[m][e] = silu_f(c) * (acc[ai][1][m][n][e] * rs[m] + bvn[e]);
                    }
                }
#pragma unroll
                for (int m = 0; m < 4; ++m) {
                    u32x2 w; w.x = cvt_pk_bf16(uv[m][0], uv[m][1]); w.y = cvt_pk_bf16(uv[m][2], uv[m][3]);
                    *(u32x2*)(U + (size_t)(u.pm * 256 + ai * 128 + wr * 64 + m * 16 + fr) * DFF + f0 + 4 * n) = w;
                }
            }
        }
#undef GLU_RS
    }
};

struct Args {
    const float* in[21];
    float* out;
    unsigned char* ws;
};

__device__ __forceinline__ void transpose_item(const float* W, int K, int N, bf16* WT, LAS float* scr, int item, int lane, bool glu) {
    const int nblk = N / 32, kb = item / nblk, nb = item % nblk, k0 = 64 * kb, n0 = 32 * nb;
#pragma unroll 8
    for (int i = 0; i < 32; ++i) { const int kk = 2 * i + (lane >> 5); scr[kk * 33 + (lane & 31)] = W[(size_t)(k0 + kk) * N + n0 + (lane & 31)]; }
    asm volatile("s_waitcnt lgkmcnt(0)" ::: "memory");
    const int c = lane & 7;
    const int r0 = !glu ? n0 : (n0 < DFF ? (n0 >> 7) * 256 + (n0 & 127) : ((n0 - DFF) >> 7) * 256 + 128 + ((n0 - DFF) & 127));
#pragma unroll
    for (int j = 0; j < 4; ++j) { const int n = (lane >> 3) + 8 * j; const LAS float* s = scr + (8 * c) * 33 + n;
        u32x4 o; o.x = cvt_pk_bf16(s[0 * 33], s[1 * 33]); o.y = cvt_pk_bf16(s[2 * 33], s[3 * 33]); o.z = cvt_pk_bf16(s[4 * 33], s[5 * 33]); o.w = cvt_pk_bf16(s[6 * 33], s[7 * 33]);
        *(u32x4*)(WT + (size_t)(r0 + n) * K + k0 + 8 * c) = o; }
    asm volatile("s_waitcnt lgkmcnt(0)" ::: "memory");
}

__device__ __forceinline__ void prologue_phase(LAS unsigned char* lds, const Args& a, int G, int bid) {
    const int tid = opaque_tid(), lane = tid & 63, wave = tid >> 6;
    unsigned char* ws = a.ws;
    {
        LAS float* scr = (LAS float*)(lds + wave * 16384);
        const int gw = bid * NWAVES + wave, NGW = G * NWAVES;
        for (int mi = 0; mi < 16; ++mi) {
            const float* src; bf16* dst; int K, N;
            if (mi < 2)       { const int j = mi;      K = DM;  N = AIN; src = a.in[8]  + (size_t)j * DM * AIN;  dst = (bf16*)(ws + WS_WAIN)  + (size_t)j * AIN * DM; }
            else if (mi < 4)  { const int j = mi - 2;  K = DM;  N = DM;  src = a.in[9]  + (size_t)j * DM * DM;   dst = (bf16*)(ws + WS_WAOUT) + (size_t)j * DM * DM; }
            else if (mi < 6)  { const int j = mi - 4;  K = DM;  N = HIN; src = a.in[13] + (size_t)j * DM * HIN;  dst = (bf16*)(ws + WS_WHIN)  + (size_t)j * HIN * DM; }
            else if (mi < 8)  { const int j = mi - 6;  K = DM;  N = DM;  src = a.in[14] + (size_t)j * DM * DM;   dst = (bf16*)(ws + WS_WHOUT) + (size_t)j * DM * DM; }
            else if (mi < 12) { const int j = mi - 8;  K = DM;  N = FUP; src = a.in[17] + (size_t)j * DM * FUP;  dst = (bf16*)(ws + WS_WUP)   + (size_t)j * FUP * DM; }
            else              { const int j = mi - 12; K = DFF; N = DM;  src = a.in[20] + (size_t)j * DFF * DM;  dst = (bf16*)(ws + WS_WDN)   + (size_t)j * DM * DFF; }
            const int nitems = (K / 64) * (N / 32);
            for (int it = gw; it < nitems; it += NGW) transpose_item(src, K, N, dst, scr, it, lane, mi >= 8 && mi < 12);
        }
    }
    {
        const int gt = bid * NTHR + tid;
        if (gt < 1024) {
            const float* lg = a.in[16];
            const float l0 = lg[gt], l1 = lg[1024 + gt], l2 = lg[2048 + gt], l3 = lg[3072 + gt];
            const float mx = fmaxf(fmaxf(l0, l1), fmaxf(l2, l3));
            const float e0 = expf(l0 - mx), e1 = expf(l1 - mx), e2 = expf(l2 - mx), e3 = expf(l3 - mx);
            const float inv = 1.0f / (e0 + e1 + e2 + e3);
            float* lbs = (float*)(ws + WS_LBS);
            lbs[gt] = 0.f; lbs[1024 + gt] = e1 * inv; lbs[2048 + gt] = (e1 + e2) * inv; lbs[3072 + gt] = (e1 + e2 + e3) * inv;
        } else if (gt < 2048) {
            const int idx = gt - 1024, pos = idx >> 4, i = idx & 15;
            const float inv = powf(10000.0f, -(float)i / 16.0f);
            const float ang = (float)pos * inv;
            float* rp = (float*)(ws + WS_ROPE);
            rp[2 * idx] = cosf(ang); rp[2 * idx + 1] = sinf(ang);
        }
    }
    __syncthreads();
    {
        LAS float* sc = (LAS float*)lds;
        LAS float* red = (LAS float*)(lds + 81920);
        for (int e = tid; e < 17 * 1024; e += NTHR) {
            const int i = e >> 10, k = e & 1023;
            const float v = (i < 16) ? a.in[1][i * 1024 + k] : a.in[3][k];
            sc[k * 20 + i] = v / (1.0f + expf(-v));
        }
        __syncthreads();
        float* MOD = (float*)(ws + WS_MOD);
        for (int item = bid; item < 4 * 96; item += G) {
            const int l = item / 96, n0 = (item % 96) * 64;
            const float* W = a.in[4] + (size_t)l * DM * 6144 + n0 + lane;
            float accv[17];
#pragma unroll
            for (int i = 0; i < 17; ++i) accv[i] = 0.f;
            const int kbeg = wave * 128;
#pragma unroll 4
            for (int kk = 0; kk < 128; ++kk) {
                const int k = kbeg + kk;
                const float w = W[(size_t)k * 6144];
                const LAS float* s = sc + k * 20;
                const f32x4 s0 = *(const LAS f32x4*)(s), s1 = *(const LAS f32x4*)(s + 4), s2 = *(const LAS f32x4*)(s + 8), s3 = *(const LAS f32x4*)(s + 12);
                const float s16 = s[16];
#pragma unroll
                for (int e = 0; e < 4; ++e) { accv[e] += s0[e] * w; accv[4 + e] += s1[e] * w; accv[8 + e] += s2[e] * w; accv[12 + e] += s3[e] * w; }
                accv[16] += s16 * w;
            }
#pragma unroll
            for (int i = 0; i < 17; ++i) red[(wave * 17 + i) * 64 + lane] = accv[i];
            __syncthreads();
            for (int o = tid; o < 17 * 64; o += NTHR) {
                const int i = o >> 6, c = o & 63;
                float s = 0.f;
#pragma unroll
                for (int w = 0; w < 8; ++w) s += red[(w * 17 + i) * 64 + c];
                MOD[((size_t)l * 17 + i) * 6144 + n0 + c] = s + a.in[5][l * 6144 + n0 + c];
            }
            __syncthreads();
        }
    }
}

__device__ __forceinline__ void init_phase(const float* xlat, const float* xctx, const float* gain, const float* modl, bf16* XB, float* rowss, int G, int bid) {
    const int tid = opaque_tid(), lane = tid & 63, wave = tid >> 6;
    const int gw = bid * NWAVES + wave, NGW = G * NWAVES;
    f32x4 gn[4];
#pragma unroll
    for (int j = 0; j < 4; ++j) gn[j] = *((const f32x4*)gain + lane + 64 * j);
    for (int row = gw; row < MTOT; row += NGW) {
        const bool isctx = row >= MLAT;
        const float* xr = isctx ? xctx + (size_t)(row - MLAT) * DM : xlat + (size_t)row * DM;
        const float* mr = modl + (size_t)(isctx ? 16 : (row >> 12)) * 6144 + 1024;
        f32x4 v[4]; float s = 0.f;
#pragma unroll
        for (int j = 0; j < 4; ++j) { v[j] = *((const f32x4*)xr + lane + 64 * j); s += (v[j][0] * v[j][0] + v[j][1] * v[j][1]) + (v[j][2] * v[j][2] + v[j][3] * v[j][3]); }
#pragma unroll
        for (int o = 1; o < 64; o <<= 1) s += __shfl_xor(s, o);
        if (lane == 0) rowss[row] = s;
        unsigned long long* o8 = (unsigned long long*)(XB + (size_t)row * DM) + lane;
#pragma unroll
        for (int j = 0; j < 4; ++j) {
            const f32x4 sc = *((const f32x4*)mr + lane + 64 * j);
            f32x4 y;
#pragma unroll
            for (int e = 0; e < 4; ++e) y[e] = v[j][e] * gn[j][e] * (1.0f + sc[e]);
            o8[64 * j] = (unsigned long long)cvt_pk_bf16(y[0], y[1]) | ((unsigned long long)cvt_pk_bf16(y[2], y[3]) << 32);
        }
    }
}
__device__ __forceinline__ void bias_phase(LAS unsigned char* lds, const float* MOD, const unsigned char* ws, float* BIAS, int G, int bid) {
    const int tid = opaque_tid(), lane = tid & 63, wave = tid >> 6;
    LAS float* sh = (LAS float*)lds;
    LAS float* red = (LAS float*)(lds + 81920);
    int cur_inst = -1;
    for (int item = bid; item < 560; item += G) {
        int inst, n0;
        {
            int r = item; inst = 0;
#pragma unroll 1
            for (;;) { const int cnt = (inst & 1) ? 88 : (((inst >> 1) & 1) ? 80 : 24); if (r < cnt) break; r -= cnt; ++inst; }
            n0 = r * 64;
        }
        const int layer = inst >> 1, half = inst & 1, j = layer >> 1;
        const int N = half ? FUP : ((layer & 1) ? HIN : AIN);
        const bf16* WT = half ? (const bf16*)(ws + WS_WUP) + (size_t)layer * FUP * DM : ((layer & 1) ? (const bf16*)(ws + WS_WHIN) + (size_t)j * HIN * DM : (const bf16*)(ws + WS_WAIN) + (size_t)j * AIN * DM);
        if (inst != cur_inst) {
            __syncthreads();
            const float* mp = MOD + (size_t)layer * 17 * 6144 + (half ? 3 : 0) * 1024;
            for (int e = tid; e < 17 * 1024; e += NTHR) { const int i = e >> 10, k = e & 1023; sh[k * 20 + i] = mp[(size_t)i * 6144 + k]; }
            cur_inst = inst;
            __syncthreads();
        }
        float accv[17];
#pragma unroll
        for (int i = 0; i < 17; ++i) accv[i] = 0.f;
        const bf16* wr_ = WT + (size_t)(n0 + lane) * DM + wave * 128;
#pragma unroll 2
        for (int kk = 0; kk < 128; kk += 8) {
            const u32x4 w = *(const u32x4*)(wr_ + kk);
            float wf[8];
#pragma unroll
            for (int q = 0; q < 4; ++q) { wf[2 * q] = bflo(w[q]); wf[2 * q + 1] = bfhi(w[q]); }
#pragma unroll
            for (int q = 0; q < 8; ++q) {
                const LAS float* sp = sh + (wave * 128 + kk + q) * 20;
                const f32x4 s0 = *(const LAS f32x4*)sp, s1 = *(const LAS f32x4*)(sp + 4), s2 = *(const LAS f32x4*)(sp + 8), s3 = *(const LAS f32x4*)(sp + 12);
                const float s16 = sp[16];
#pragma unroll
                for (int e = 0; e < 4; ++e) { accv[e] += s0[e] * wf[q]; accv[4 + e] += s1[e] * wf[q]; accv[8 + e] += s2[e] * wf[q]; accv[12 + e] += s3[e] * wf[q]; }
                accv[16] += s16 * wf[q];
            }
        }
#pragma unroll
        for (int i = 0; i < 17; ++i) red[(wave * 17 + i) * 64 + lane] = accv[i];
        __syncthreads();
        for (int o = tid; o < 17 * 64; o += NTHR) {
            const int i = o >> 6, c = o & 63;
            float sum = 0.f;
#pragma unroll
            for (int w = 0; w < 8; ++w) sum += red[(w * 17 + i) * 64 + c];
            BIAS[((size_t)inst * 17 + i) * FUP + n0 + c] = sum;
        }
        __syncthreads();
    }
}

__device__ __forceinline__ void kprep_phase(LAS unsigned char* lds, bf16* qkv, const float* kgain, const float* ropetab, int G, int bid) {
    const int tid = opaque_tid();
    LAS f32x2* rope = (LAS f32x2*)lds;
    for (int i = tid; i < 1024; i += NTHR) rope[i] = ((const f32x2*)ropetab)[i];
    const int c = tid & 7;
    float gk[8];
#pragma unroll
    for (int e = 0; e < 8; ++e) gk[e] = kgain[c * 8 + e];
    __syncthreads();
    for (int item = (bid * NTHR + tid) >> 3; item < MTOT * 4; item += (G * NTHR) >> 3) {
        const int row = item >> 2, kh = item & 3;
        bf16* kp = qkv + (size_t)row * AIN + 1024 + kh * 64 + c * 8;
        const u32x4 r = *(const u32x4*)kp;
        float y[8];
#pragma unroll
        for (int w = 0; w < 4; ++w) { y[2 * w] = bflo(r[w]); y[2 * w + 1] = bfhi(r[w]); }
        float ss = 0.f;
#pragma unroll
        for (int e = 0; e < 8; ++e) ss += y[e] * y[e];
        ss += __shfl_xor(ss, 1); ss += __shfl_xor(ss, 2); ss += __shfl_xor(ss, 4);
        const float rs = rsqrtf(ss * (1.0f / 64.0f) + EPS);
#pragma unroll
        for (int e = 0; e < 8; ++e) y[e] = y[e] * rs * gk[e];
        if (row < MLAT) {
            const int t = row & (SEQ - 1), p = (c < 4) ? (t >> 6) : (t & 63);
#pragma unroll
            for (int e = 0; e < 8; ++e) {
                const f32x2 cs = rope[p * 16 + (c & 1) * 8 + e];
                const float own = y[e], oth = __shfl_xor(own, 2);
                y[e] = (c & 2) ? (oth * cs[1] + own * cs[0]) : (own * cs[0] - oth * cs[1]);
            }
        }
        u32x4 w; w.x = cvt_pk_bf16(y[0], y[1]); w.y = cvt_pk_bf16(y[2], y[3]); w.z = cvt_pk_bf16(y[4], y[5]); w.w = cvt_pk_bf16(y[6], y[7]);
        *(u32x4*)kp = w;
    }
    __syncthreads();
}

__device__ __forceinline__ void attn_phase(LAS unsigned char* lds, bf16* qkv, const float* qgain, const float* kgain, const float* sink, const float* ropetab, int G, int bid) {
    const int tid = opaque_tid(), lane = tid & 63, wave = tid >> 6, fr = lane & 15, fq = lane >> 4;
    LAS unsigned char* Ks = lds;
    LAS unsigned char* Vt = lds + 20480;
    LAS f32x2* rope = (LAS f32x2*)(lds + 38912);
    for (int i = tid; i < 1024; i += NTHR) rope[i] = ((const f32x2*)ropetab)[i];
    float mq = 0.f, mk = 0.f;
    for (int d = 0; d < 64; ++d) { mq = fmaxf(mq, fabsf(qgain[d])); mk = fmaxf(mk, fabsf(kgain[d])); }
    const float Mshift = 8.0f * mq * mk * LOG2E;
    __syncthreads();
    const int g = wave >> 1, whalf = wave & 1;
    for (int u = bid; u < 34 * 64; u += G) {
        const int qb = u >> 6, rem = u & 63, b = rem >> 2, kh = rem & 3;
        const bool qctx = qb >= 32;
        const int hq = kh * 4 + g;
        const int qrow0 = qctx ? (MLAT + b * CTXL + (qb - 32) * 128 + whalf * 64) : (b * SEQ + qb * 128 + whalf * 64);
        bf16x8 qf[4][2];
        float gq[16];
#pragma unroll
        for (int e = 0; e < 8; ++e) { gq[e] = qgain[fq * 8 + e]; gq[8 + e] = qgain[32 + fq * 8 + e]; }
#pragma unroll
        for (int qi = 0; qi < 4; ++qi) {
            const bf16* qp = qkv + (size_t)(qrow0 + qi * 16 + fr) * AIN + hq * 64 + fq * 8;
            const u32x4 r0 = *(const u32x4*)qp, r1 = *(const u32x4*)(qp + 32);
            float y[16];
#pragma unroll
            for (int w = 0; w < 4; ++w) { y[2 * w] = bflo(r0[w]); y[2 * w + 1] = bfhi(r0[w]); y[8 + 2 * w] = bflo(r1[w]); y[8 + 2 * w + 1] = bfhi(r1[w]); }
            float ss = 0.f;
#pragma unroll
            for (int e = 0; e < 16; ++e) ss += y[e] * y[e];
            ss += __shfl_xor(ss, 16); ss += __shfl_xor(ss, 32);
            const float rs = rsqrtf(ss * (1.0f / 64.0f) + EPS);
#pragma unroll
            for (int e = 0; e < 16; ++e) y[e] = y[e] * rs * gq[e];
            if (!qctx) {
                const int t = qb * 128 + whalf * 64 + qi * 16 + fr, prow = t >> 6, pcol = t & 63;
#pragma unroll
                for (int dh = 0; dh < 2; ++dh)
#pragma unroll
                    for (int e = 0; e < 8; ++e) {
                        const f32x2 cs = rope[(dh ? pcol : prow) * 16 + (fq & 1) * 8 + e];
                        const float own = y[dh * 8 + e], oth = __shfl_xor(own, 32);
                        y[dh * 8 + e] = (fq & 2) ? (oth * cs[1] + own * cs[0]) : (own * cs[0] - oth * cs[1]);
                    }
            }
            const float QS = 0.125f * LOG2E;
#pragma unroll
            for (int dh = 0; dh < 2; ++dh) {
                u32x4 w;
                w.x = cvt_pk_bf16(y[dh * 8 + 0] * QS, y[dh * 8 + 1] * QS); w.y = cvt_pk_bf16(y[dh * 8 + 2] * QS, y[dh * 8 + 3] * QS);
                w.z = cvt_pk_bf16(y[dh * 8 + 4] * QS, y[dh * 8 + 5] * QS); w.w = cvt_pk_bf16(y[dh * 8 + 6] * QS, y[dh * 8 + 7] * QS);
                qf[qi][dh] = __builtin_bit_cast(bf16x8, w);
            }
        }
        f32x4 o[4][4];
#pragma unroll
        for (int dt = 0; dt < 4; ++dt)
#pragma unroll
            for (int qi = 0; qi < 4; ++qi) o[dt][qi] = (f32x4){0.f, 0.f, 0.f, 0.f};
        float lsum[4] = {0.f, 0.f, 0.f, 0.f};
#define ATT_VALID(s_) ((s_) >= 3 ? true : (!qctx && (qb - 1 + (s_)) >= 0 && (qb - 1 + (s_)) <= 31))
#define ATT_KROW(s_) ((s_) >= 3 ? (MLAT + b * CTXL + ((s_) - 3) * 128) : (b * SEQ + (qb - 1 + (s_)) * 128))
#define ATT_FETCH(s_) do { const int kr_ = ATT_KROW(s_); \
            const bf16* kp_ = qkv + (size_t)(kr_ + (tid >> 3)) * AIN + 1024 + kh * 64 + (tid & 7) * 8; \
            pk0 = *(const u32x4*)kp_; pk1 = *(const u32x4*)(kp_ + (size_t)64 * AIN); \
            const bf16* vp_ = qkv + (size_t)(kr_ + 2 * (tid >> 3)) * AIN + 1280 + kh * 64 + (tid & 7) * 8; \
            pv0 = *(const u32x4*)vp_; pv1 = *(const u32x4*)(vp_ + AIN); } while (0)
        u32x4 pk0, pk1, pv0, pv1;
        int sb = 0;
        while (sb < 5 && !ATT_VALID(sb)) ++sb;
        ATT_FETCH(sb);
        while (sb < 5) {
            const int type = sb < 3 ? sb : 3;
            asm volatile("s_waitcnt lgkmcnt(0)" ::: "memory"); __builtin_amdgcn_s_barrier(); asm volatile("" ::: "memory");
            {
                const int key = tid >> 3, c = tid & 7;
                *(LAS u32x4*)(Ks + key * 160 + c * 16) = pk0;
                *(LAS u32x4*)(Ks + (key + 64) * 160 + c * 16) = pk1;
                const int kp = tid >> 3;
#pragma unroll
                for (int w = 0; w < 4; ++w) {
                    const unsigned lo = (pv0[w] & 0xffffu) | (pv1[w] << 16), hi = (pv0[w] >> 16) | (pv1[w] & 0xffff0000u);
                    *(LAS unsigned*)(Vt + (c * 8 + 2 * w) * 272 + kp * 4) = lo;
                    *(LAS unsigned*)(Vt + (c * 8 + 2 * w + 1) * 272 + kp * 4) = hi;
                }
            }
            int nsb = sb + 1;
            while (nsb < 5 && !ATT_VALID(nsb)) ++nsb;
            if (nsb < 5) ATT_FETCH(nsb);
            asm volatile("s_waitcnt lgkmcnt(0)" ::: "memory"); __builtin_amdgcn_s_barrier(); asm volatile("" ::: "memory");
            const int msg = (type == 0) ? 1 : (type == 2 ? -1 : 0);
#pragma unroll 1
            for (int T = 0; T < 4; ++T) {
                bf16x8 kf[2][2];
#pragma unroll
                for (int sub = 0; sub < 2; ++sub)
#pragma unroll
                    for (int dh = 0; dh < 2; ++dh) kf[sub][dh] = *(const LAS bf16x8*)(Ks + (T * 32 + sub * 16 + fr) * 160 + dh * 64 + fq * 16);
                bf16x8 pb[4];
#pragma unroll
                for (int qi = 0; qi < 4; ++qi) {
                    f32x4 s0 = (f32x4){0.f, 0.f, 0.f, 0.f}, s1 = (f32x4){0.f, 0.f, 0.f, 0.f};
                    s0 = __builtin_amdgcn_mfma_f32_16x16x32_bf16(kf[0][0], qf[qi][0], s0, 0, 0, 0);
                    s0 = __builtin_amdgcn_mfma_f32_16x16x32_bf16(kf[0][1], qf[qi][1], s0, 0, 0, 0);
                    s1 = __builtin_amdgcn_mfma_f32_16x16x32_bf16(kf[1][0], qf[qi][0], s1, 0, 0, 0);
                    s1 = __builtin_amdgcn_mfma_f32_16x16x32_bf16(kf[1][1], qf[qi][1], s1, 0, 0, 0);
                    const int mbase = msg * (T * 32 + fq * 4 - (whalf * 64 + qi * 16 + fr));
                    float p0[4], p1[4];
#pragma unroll
                    for (int j = 0; j < 4; ++j) {
                        const float e0 = __builtin_amdgcn_exp2f(s0[j] - Mshift), e1 = __builtin_amdgcn_exp2f(s1[j] - Mshift);
                        p0[j] = (mbase + msg * j >= 0) ? e0 : 0.f;
                        p1[j] = (mbase + msg * (16 + j) >= 0) ? e1 : 0.f;
                    }
                    lsum[qi] += (p0[0] + p0[1]) + (p0[2] + p0[3]) + (p1[0] + p1[1]) + (p1[2] + p1[3]);
                    u32x4 w; w.x = cvt_pk_bf16(p0[0], p0[1]); w.y = cvt_pk_bf16(p0[2], p0[3]); w.z = cvt_pk_bf16(p1[0], p1[1]); w.w = cvt_pk_bf16(p1[2], p1[3]);
                    pb[qi] = __builtin_bit_cast(bf16x8, w);
                }
#pragma unroll
                for (int dt = 0; dt < 4; ++dt) {
                    const LAS unsigned char* vp = Vt + (dt * 16 + fr) * 272 + (T * 32 + fq * 4) * 2;
                    const u32x2 lo = *(const LAS u32x2*)vp, hi = *(const LAS u32x2*)(vp + 32);
                    u32x4 w; w.x = lo[0]; w.y = lo[1]; w.z = hi[0]; w.w = hi[1];
                    const bf16x8 vf = __builtin_bit_cast(bf16x8, w);
#pragma unroll
                    for (int qi = 0; qi < 4; ++qi) o[dt][qi] = __builtin_amdgcn_mfma_f32_16x16x32_bf16(vf, pb[qi], o[dt][qi], 0, 0, 0);
                }
            }
            sb = nsb;
        }
#undef ATT_VALID
#undef ATT_KROW
#undef ATT_FETCH
        const float sk = __builtin_amdgcn_exp2f(sink[hq] * LOG2E - Mshift);
#pragma unroll
        for (int qi = 0; qi < 4; ++qi) {
            float l = lsum[qi];
            l += __shfl_xor(l, 16); l += __shfl_xor(l, 32);
            const float inv = 1.0f / (l + sk);
            bf16* op = qkv + (size_t)(qrow0 + qi * 16 + fr) * AIN + hq * 64 + fq * 4;
#pragma unroll
            for (int dt = 0; dt < 4; ++dt) {
                const f32x4 v = o[dt][qi];
                u32x2 w; w.x = cvt_pk_bf16(v[0] * inv, v[1] * inv); w.y = cvt_pk_bf16(v[2] * inv, v[3] * inv);
                *(u32x2*)(op + dt * 16) = w;
            }
        }
    }
    __syncthreads();
}

__device__ __forceinline__ int scan_row16(int b, int dir, int c, int t) {
    if (c < 16) { const int p = c * 16 + t; return MLAT + b * CTXL + (dir ? (CTXL - 1 - p) : p); }
    const int p = (c - 16) * 16 + t; return b * SEQ + (dir ? (SEQ - 1 - p) : p);
}
__device__ __forceinline__ void scan_phase(LAS unsigned char* lds, bf16* proj, int G, int bid) {
    const int tid = opaque_tid(), lane = tid & 63, wave = tid >> 6, fr = lane & 15, fq = lane >> 4;
    constexpr int KRS = 132;
    constexpr int SET = 34304, O_KR = 0, O_QR = 8448, O_QE = 16896, O_KE = 21248, O_KD = 25600, O_DV = 33792, O_VT = 2 * SET, QST = 272;
    const int st = tid >> 4, sc8 = tid & 15;
    const int pdk = tid >> 2, ptq = tid & 3;
    const bool stager = tid < 256;
#define SC_LOAD(c_) do { const bf16* rp_ = proj + (size_t)scan_row16(b, dir, (c_), st) * HIN + h * 128 + sc8 * 8; \
        rq = *(const u32x4*)rp_; rk = *(const u32x4*)(rp_ + kcol - h * 128); rv = *(const u32x4*)(rp_ + 3072); } while (0)
#define SC_WRITE(c_) do { LAS float* kd_ = (LAS float*)(lds + ((c_) & 1) * SET + O_KR) + st * KRS + sc8 * 8; LAS float* qd_ = (LAS float*)(lds + ((c_) & 1) * SET + O_QR) + st * KRS + sc8 * 8; \
        LAS unsigned short* vd_ = (LAS unsigned short*)(lds + O_VT + ((c_) % 3) * 8192) + (sc8 * 8) * 32 + (st >> 2) * 8 + (st & 3); \
        _Pragma("unroll") for (int w_ = 0; w_ < 4; ++w_) { kd_[2 * w_] = bflo(rk[w_]); kd_[2 * w_ + 1] = bfhi(rk[w_]); qd_[2 * w_] = bflo(rq[w_]); qd_[2 * w_ + 1] = bfhi(rq[w_]); \
            vd_[(2 * w_) * 32] = (unsigned short)(rv[w_] & 0xffffu); vd_[(2 * w_ + 1) * 32] = (unsigned short)(rv[w_] >> 16); } } while (0)
    for (int chain = bid; chain < 256; chain += G) {
        const int b = chain >> 4, h = (chain >> 1) & 7, dir = chain & 1;
        const int kcol = 1024 + dir * 1024 + h * 128;
        f32x4 S[8];
#pragma unroll
        for (int i = 0; i < 8; ++i) S[i] = (f32x4){0.f, 0.f, 0.f, 0.f};
        u32x4 rk = (u32x4){0u, 0u, 0u, 0u}, rq = rk, rv = rk;
#define SC_QUAD(v_, ctrl_) __builtin_bit_cast(float, __builtin_amdgcn_update_dpp(0, __builtin_bit_cast(int, (v_)), (ctrl_), 0xf, 0xf, false))
#define SC_PREP(cp_) do { LAS unsigned char* pset_ = lds + ((cp_) & 1) * SET; \
            const LAS float* kr_ = (const LAS float*)(pset_ + O_KR) + (ptq * 4) * KRS + pdk; \
            const LAS float* qr_ = (const LAS float*)(pset_ + O_QR) + (ptq * 4) * KRS + pdk; \
            float kk_[4], qq_[4], ff_[4]; \
            _Pragma("unroll") for (int i_ = 0; i_ < 4; ++i_) { kk_[i_] = kr_[i_ * KRS]; qq_[i_] = qr_[i_ * KRS]; } \
            ff_[0] = fmaxf(1.0f - kk_[0], 0.0067f); \
            _Pragma("unroll") for (int i_ = 1; i_ < 4; ++i_) ff_[i_] = ff_[i_ - 1] * fmaxf(1.0f - kk_[i_], 0.0067f);        \
              \
            float inc_ = ff_[3]; \
            { const float s1_ = SC_QUAD(inc_, 0x90); inc_ = (ptq >= 1) ? inc_ * s1_ : inc_; }        \
            { const float s2_ = SC_QUAD(inc_, 0x40); inc_ = (ptq >= 2) ? inc_ * s2_ : inc_; }        \
            const float prev_ = SC_QUAD(inc_, 0x90); const float exc_ = (ptq >= 1) ? prev_ : 1.0f;     \
            const float bs_ = SC_QUAD(inc_, 0xFF);                                                    \
            LAS unsigned short* qe_ = (LAS unsigned short*)(pset_ + O_QE) + (ptq * 4) * (QST / 2) + pdk; \
            LAS unsigned short* ke_ = (LAS unsigned short*)(pset_ + O_KE) + (ptq * 4) * (QST / 2) + pdk; \
            float kd_[4]; \
            _Pragma("unroll") for (int i_ = 0; i_ < 4; ++i_) { const float F_ = exc_ * ff_[i_]; const float inv_ = fast_rcp(F_); const float qv_ = qq_[i_] * F_, kev_ = kk_[i_] * inv_; kd_[i_] = kev_ * bs_; \
                const unsigned pk_ = cvt_pk_bf16(qv_, kev_); qe_[i_ * (QST / 2)] = (unsigned short)(pk_ & 0xffffu); ke_[i_ * (QST / 2)] = (unsigned short)(pk_ >> 16); } \
            u32x2 kw_; kw_.x = cvt_pk_bf16(kd_[0], kd_[1]); kw_.y = cvt_pk_bf16(kd_[2], kd_[3]); \
            *(LAS u32x2*)(pset_ + O_KD + pdk * 64 + ptq * 16) = kw_; \
            if (ptq == 0) ((LAS float*)(pset_ + O_DV))[pdk] = bs_; } while (0)
        __syncthreads();
        {
            const u32x4 z4 = (u32x4){0u, 0u, 0u, 0u};
            for (int o_ = tid * 16; o_ < 8192; o_ += NTHR * 16) { *(LAS u32x4*)(lds + O_KD + o_) = z4; *(LAS u32x4*)(lds + SET + O_KD + o_) = z4; *(LAS u32x4*)(lds + O_VT + o_) = z4; *(LAS u32x4*)(lds + O_VT + 8192 + o_) = z4; *(LAS u32x4*)(lds + O_VT + 16384 + o_) = z4; }
        }
        if (stager) SC_LOAD(0);
        __syncthreads();
        if (stager) { SC_WRITE(0); SC_LOAD(1); }
        __syncthreads();
        SC_PREP(0);
        if (stager) { SC_WRITE(1); SC_LOAD(2); }
        __syncthreads();
#pragma unroll 1
        for (int c = 0; c < 272; ++c) {
            LAS unsigned char* set = lds + (c & 1) * SET;
            SC_PREP(c + 1);
            {
                const LAS unsigned char* qeb = set + O_QE + fr * QST; const LAS unsigned char* keb = set + O_KE + fr * QST;
                bf16x8 kaf[4], qbf[4];
#pragma unroll
                for (int i = 0; i < 4; ++i) { kaf[i] = *(const LAS bf16x8*)(keb + (32 * i + fq * 8) * 2); qbf[i] = *(const LAS bf16x8*)(qeb + (32 * i + fq * 8) * 2); }
                u32x2 qlo[4], qhi[4];
#pragma unroll
                for (int i = 0; i < 4; ++i) { qlo[i] = *(const LAS u32x2*)(qeb + (32 * i + fq * 4) * 2); qhi[i] = *(const LAS u32x2*)(qeb + (32 * i + 16 + fq * 4) * 2); }
                const bf16x8 vf = *(const LAS bf16x8*)(lds + O_VT + (c % 3) * 8192 + (wave * 16 + fr) * 64 + fq * 16);
                f32x4 pt = (f32x4){0.f, 0.f, 0.f, 0.f};
#pragma unroll
                for (int i = 0; i < 4; ++i) pt = __builtin_amdgcn_mfma_f32_16x16x32_bf16(kaf[i], qbf[i], pt, 0, 0, 0);
                f32x4 oacc = (f32x4){0.f, 0.f, 0.f, 0.f};
#pragma unroll
                for (int i = 0; i < 4; ++i) {
                    u32x4 sw; sw.x = cvt_pk_bf16(S[2 * i][0], S[2 * i][1]); sw.y = cvt_pk_bf16(S[2 * i][2], S[2 * i][3]); sw.z = cvt_pk_bf16(S[2 * i + 1][0], S[2 * i + 1][1]); sw.w = cvt_pk_bf16(S[2 * i + 1][2], S[2 * i + 1][3]);
                    u32x4 qw; qw.x = qlo[i][0]; qw.y = qlo[i][1]; qw.z = qhi[i][0]; qw.w = qhi[i][1];
                    oacc = __builtin_amdgcn_mfma_f32_16x16x32_bf16(__builtin_bit_cast(bf16x8, sw), __builtin_bit_cast(bf16x8, qw), oacc, 0, 0, 0);
                }
                const LAS float* dv = (const LAS float*)(set + O_DV);
#pragma unroll
                for (int kt = 0; kt < 8; ++kt) {
                    const f32x4 d4 = *(const LAS f32x4*)(dv + kt * 16 + fq * 4);
                    const bf16x8 ka = *(const LAS bf16x8*)(set + O_KD + (kt * 16 + fr) * 64 + fq * 16);
                    S[kt] = __builtin_amdgcn_mfma_f32_16x16x32_bf16(ka, vf, S[kt] * d4, 0, 0, 0);
                }
#pragma unroll
                for (int j = 0; j < 4; ++j) pt[j] = (fq * 4 + j <= fr) ? pt[j] : 0.f;
                u32x4 pw; pw.x = cvt_pk_bf16(pt[0], pt[1]); pw.y = cvt_pk_bf16(pt[2], pt[3]); pw.z = 0u; pw.w = 0u;
                oacc = __builtin_amdgcn_mfma_f32_16x16x32_bf16(vf, __builtin_bit_cast(bf16x8, pw), oacc, 0, 0, 0);
                {
                    u32x2 ow; ow.x = cvt_pk_bf16(oacc[0], oacc[1]); ow.y = cvt_pk_bf16(oacc[2], oacc[3]);
                    *(u32x2*)(proj + (size_t)scan_row16(b, dir, c, fr) * HIN + kcol + wave * 16 + fq * 4) = ow;
                }
            }
            if (stager) { if (c + 2 < 272) SC_WRITE(c + 2); if (c + 3 < 272) SC_LOAD(c + 3); }
            asm volatile("s_waitcnt lgkmcnt(0)" ::: "memory"); __builtin_amdgcn_s_barrier(); asm volatile("" ::: "memory");
        }
        __syncthreads();
    }
#undef SC_PREP
#undef SC_QUAD
#undef SC_LOAD
#undef SC_WRITE
}
__device__ __forceinline__ void readout_phase(const bf16* proj, const float* ogain, bf16* H, int nrows, int G, int bid) {
    const int tid = opaque_tid(), lane = tid & 63, wave = tid >> 6;
    const int gw = bid * NWAVES + wave, NGW = G * NWAVES;
    float gn[16];
#pragma unroll
    for (int e = 0; e < 16; ++e) gn[e] = ogain[(lane & 7) * 16 + e];
    for (int row = gw; row < nrows; row += NGW) {
        const bf16* rp = proj + (size_t)row * HIN + lane * 16;
        float o[16], gt[16];
#pragma unroll
        for (int hh = 0; hh < 2; ++hh) {
            const u32x4 f = *(const u32x4*)(rp + 1024 + hh * 8), bw = *(const u32x4*)(rp + 2048 + hh * 8), gg = *(const u32x4*)(rp + 4096 + hh * 8);
#pragma unroll
            for (int w = 0; w < 4; ++w) {
                o[hh * 8 + 2 * w] = bflo(f[w]) + bflo(bw[w]); o[hh * 8 + 2 * w + 1] = bfhi(f[w]) + bfhi(bw[w]);
                gt[hh * 8 + 2 * w] = bflo(gg[w]); gt[hh * 8 + 2 * w + 1] = bfhi(gg[w]);
            }
        }
        float ss = 0.f;
#pragma unroll
        for (int e = 0; e < 16; ++e) ss += o[e] * o[e];
        ss += __shfl_xor(ss, 1); ss += __shfl_xor(ss, 2); ss += __shfl_xor(ss, 4);
        const float rs = rsqrtf(ss * (1.0f / 128.0f) + EPS);
        u32x4 w0, w1;
#define RO(e) (o[e] * rs * gn[e] * gt[e])
        w0.x = cvt_pk_bf16(RO(0), RO(1)); w0.y = cvt_pk_bf16(RO(2), RO(3)); w0.z = cvt_pk_bf16(RO(4), RO(5)); w0.w = cvt_pk_bf16(RO(6), RO(7));
        w1.x = cvt_pk_bf16(RO(8), RO(9)); w1.y = cvt_pk_bf16(RO(10), RO(11)); w1.z = cvt_pk_bf16(RO(12), RO(13)); w1.w = cvt_pk_bf16(RO(14), RO(15));
#undef RO
        bf16* hp = H + (size_t)row * DM + lane * 16;
        *(u32x4*)hp = w0; *(u32x4*)(hp + 8) = w1;
    }
}

__device__ __forceinline__ void glu_fix_phase(bf16* U, const float* edge, const float* cw, const float* cb, int ntiles, int G, int bid) {
    const int tid = opaque_tid();
    const int nitems = ntiles * 2 * (DFF / 4);
    for (int item = bid * NTHR + tid; item < nitems; item += G * NTHR) {
        const int f = (item % (DFF / 4)) * 4, te = item / (DFF / 4), pm = te >> 1, bot = te & 1;
        const bool isctx = pm >= 256;
        const bool first = isctx || (pm & 15) == 0, lastt = isctx || (pm & 15) == 15;
        const float* eb = edge + (size_t)pm * 6 * DFF + f;
        const f32x4 z = (f32x4){0.f, 0.f, 0.f, 0.f};
        f32x4 up, cur, dn, vl;
        if (!bot) { up = first ? z : *(const f32x4*)(eb - 3 * DFF); cur = *(const f32x4*)eb; dn = *(const f32x4*)(eb + DFF); vl = *(const f32x4*)(eb + 4 * DFF); }
        else      { up = *(const f32x4*)(eb + 2 * DFF); cur = *(const f32x4*)(eb + 3 * DFF); dn = lastt ? z : *(const f32x4*)(eb + 6 * DFF); vl = *(const f32x4*)(eb + 5 * DFF); }
        const f32x4 a0 = *(const f32x4*)(cw + f), a1 = *(const f32x4*)(cw + DFF + f), a2 = *(const f32x4*)(cw + 2 * DFF + f), bb = *(const f32x4*)(cb + f);
        float o[4];
#pragma unroll
        for (int e = 0; e < 4; ++e) o[e] = silu_f(a0[e] * up[e] + a1[e] * cur[e] + a2[e] * dn[e] + bb[e]) * vl[e];
        u32x2 w; w.x = cvt_pk_bf16(o[0], o[1]); w.y = cvt_pk_bf16(o[2], o[3]);
        *(u32x2*)(U + (size_t)(pm * 256 + (bot ? 255 : 0)) * DFF + f) = w;
    }
}

__global__ void __launch_bounds__(NTHR, 2) fwd_kernel(Args a) {
    extern __shared__ __attribute__((aligned(16))) unsigned char lds_raw[];
    LAS unsigned char* lds = (LAS unsigned char*)lds_raw;
    cg::grid_group grid = cg::this_grid();
    {
        if (threadIdx.x < 32) ((LAS unsigned*)(lds + 135168))[threadIdx.x] = 0u;
        __syncthreads();
    }
    const XcdBarrier xbar = xcd_barrier_post((unsigned*)(a.ws + WS_BAR), (volatile LAS unsigned*)(lds + 135168));
#define GRID_SYNC() xcd_barrier(xbar)
    const int G = gridDim.x, bid = blockIdx.x;
    unsigned char* ws = a.ws;
    float* MOD = (float*)(ws + WS_MOD);
    const float* LBS = (const float*)(ws + WS_LBS);
    const float* ROPE = (const float*)(ws + WS_ROPE);
    float* CTXS = (float*)(ws + WS_CTXS);
    bf16* H = (bf16*)(ws + WS_H);
    bf16* PROJ = (bf16*)(ws + WS_PROJ);
    float* EDGE = (float*)(ws + WS_EDGE);
    float* ROWSS = (float*)(ws + WS_ROWSS);
    float* BIAS = (float*)(ws + WS_BIAS);
    bf16* XB2 = (bf16*)(ws + WS_XB2);

#ifndef NO_PRO
    prologue_phase(lds, a, G, bid);
#endif
    grid.sync();
    bias_phase(lds, MOD, ws, BIAS, G, bid);
    init_phase(a.in[0], a.in[2], a.in[6], MOD, H, ROWSS, G, bid);
    GRID_SYNC();

#pragma unroll 1
    for (int layer = 0; layer < DEPTH; ++layer) {
        const bool last = layer == DEPTH - 1;
        const bool is_attn = (layer & 1) == 0;
        const int j = layer >> 1;
        const float* modl = MOD + (size_t)layer * 17 * 6144;
#pragma unroll 1
        for (int half = 0; half < 2; ++half) {
            const bool first = (layer == 0 && half == 0);
            const bool xorig = (layer == 0);
            const float* xin_lat = xorig ? a.in[0] : a.out;
            const float* xin_ctx = xorig ? a.in[2] : CTXS;
            const int nrows_x = (last && half == 1) ? MLAT : MTOT;
            const int nrows_o = last ? MLAT : MTOT;
            const int inst = layer * 2 + half;
            {
                float* z = ROWSS + ((inst + 1) & 1) * MTOT;
                for (int i = bid * NTHR + opaque_tid(); i < MTOT; i += G * NTHR) z[i] = 0.f;
            }
            const bf16* A1 = (half == 1 && !is_attn) ? XB2 : H;
            {
                pg8::Gemm g; int ldc, mode;
                if (half == 0) {
                    if (is_attn) { g = pg8::Gemm{A1, (const bf16*)(ws + WS_WAIN) + (size_t)j * AIN * DM, MTOT, AIN, DM, DM}; ldc = AIN; mode = 0; }
                    else         { g = pg8::Gemm{A1, (const bf16*)(ws + WS_WHIN) + (size_t)j * HIN * DM, MTOT, HIN, DM, DM}; ldc = HIN; mode = 1; }
                } else           { g = pg8::Gemm{A1, (const bf16*)(ws + WS_WUP) + (size_t)layer * FUP * DM, nrows_x, FUP, DM, DM}; ldc = FUP; mode = 0; }
                pg8::StaticOrder S; S.init(g.M, g.N, G, bid);
                if (half == 0) {
                    EpiAct E{PROJ, ldc, mode, LBS + layer * 1024, ROWSS + (inst & 1) * MTOT, BIAS + (size_t)inst * 17 * FUP};
                    pg8::gemm_phase<EpiAct, pg8::StaticOrder, true, true>(lds, g, S, E);
                } else {
                    EpiGLU E{PROJ, EDGE, a.in[18] + (size_t)layer * 3 * DFF, a.in[19] + (size_t)layer * DFF, (LAS float*)(lds + 131072), ROWSS + (inst & 1) * MTOT, BIAS + (size_t)inst * 17 * FUP};
                    pg8::gemm_phase<EpiGLU, pg8::StaticOrder, true, true>(lds, g, S, E);
                }
            }
            GRID_SYNC();
            if (half == 0) {
                if (is_attn) {
                    kprep_phase(lds, PROJ, a.in[11] + j * 64, ROPE, G, bid);
                    GRID_SYNC();
#ifndef NO_ATTN
                    attn_phase(lds, PROJ, a.in[10] + j * 64, a.in[11] + j * 64, a.in[12] + j * 16, ROPE, G, bid);
#endif
                } else {
#ifndef NO_SCAN
                    scan_phase(lds, PROJ, G, bid);
#endif
                    GRID_SYNC();
#ifndef NO_RO
                    readout_phase(PROJ, a.in[15] + j * 128, H, nrows_o, G, bid);
#endif
                }
            } else {
                glu_fix_phase(PROJ, EDGE, a.in[18] + (size_t)layer * 3 * DFF, a.in[19] + (size_t)layer * DFF, nrows_o / 256, G, bid);
            }
            GRID_SYNC();
            {
                pg8::Gemm g;
                if (half == 0) {
                    if (is_attn) g = pg8::Gemm{PROJ, (const bf16*)(ws + WS_WAOUT) + (size_t)j * DM * DM, nrows_o, DM, DM, AIN};
                    else         g = pg8::Gemm{H, (const bf16*)(ws + WS_WHOUT) + (size_t)j * DM * DM, nrows_o, DM, DM, DM};
                } else           g = pg8::Gemm{PROJ, (const bf16*)(ws + WS_WDN) + (size_t)layer * DM * DFF, nrows_o, DM, DFF, DFF};
                pg8::StaticOrder S; S.init(g.M, g.N, G, bid);
                const int has_next = inst < 2 * DEPTH - 1;
                const int ln = half ? (has_next ? layer + 1 : layer) : layer;
                float* rsn = ROWSS + ((inst + 1) & 1) * MTOT; const float* gnn = (half ? a.in[6] : a.in[7]) + ln * DM; const float* mdn = MOD + (size_t)ln * 17 * 6144 + (half ? 1 : 4) * 1024;
                if (half == 0) {
                    EpiRes<1> E{xin_lat, xin_ctx, a.out, CTXS, modl + 2 * 1024, is_attn ? H : XB2, rsn, gnn, mdn, has_next, (bf16*)(ws + WS_D1)};
                    pg8::gemm_phase<EpiRes<1>, pg8::StaticOrder, true, true>(lds, g, S, E);
                } else {
                    EpiRes<2> E{xin_lat, xin_ctx, a.out, CTXS, modl + 5 * 1024, H, rsn, gnn, mdn, has_next, (bf16*)(ws + WS_D1)};
                    pg8::gemm_phase<EpiRes<2>, pg8::StaticOrder, true, true>(lds, g, S, E);
                }
            }
            GRID_SYNC();
        }
    }
}

extern "C" void kernel_launch(void* const* d_in, const int* in_sizes, int n_in, void* d_out, int out_size, void* d_ws, size_t ws_size, hipStream_t stream) {
    static int grid = 0;
    if (grid == 0) {
        if (n_in != 21 || ws_size < WS_END) { fprintf(stderr, "kernel_launch: unexpected inputs (n_in %d, ws %zu, need %zu)\n", n_in, ws_size, (size_t)WS_END); grid = -1; return; }
        int dev = 0, cus = 0, per_cu = 0;
        hipGetDevice(&dev);
        hipDeviceGetAttribute(&cus, hipDeviceAttributeMultiprocessorCount, dev);
        if (hipFuncSetAttribute((const void*)fwd_kernel, hipFuncAttributeMaxDynamicSharedMemorySize, LDS_BYTES) != hipSuccess) { fprintf(stderr, "kernel_launch: hipFuncSetAttribute failed\n"); grid = -1; return; }
        if (hipOccupancyMaxActiveBlocksPerMultiprocessor(&per_cu, (const void*)fwd_kernel, NTHR, LDS_BYTES) != hipSuccess || per_cu < 1) { fprintf(stderr, "kernel_launch: occupancy query failed (%d)\n", per_cu); per_cu = 1; }
        (void)hipGetLastError();
        grid = cus * per_cu;
        fprintf(stderr, "kernel_launch: grid %d (cus %d x %d)\n", grid, cus, per_cu);
    }
    if (grid < 0) return;
    if (hipMemsetAsync((char*)d_ws + WS_BAR, 0, 16384, stream) != hipSuccess) { fprintf(stderr, "kernel_launch: memset failed\n"); return; }
    Args a{};
    for (int i = 0; i < 21; ++i) a.in[i] = (const float*)d_in[i];
    a.out = (float*)d_out; a.ws = (unsigned char*)d_ws;
    void* args[] = {&a};
    hipError_t e = hipLaunchCooperativeKernel((const void*)fwd_kernel, dim3(grid), dim3(NTHR), args, LDS_BYTES, stream);
    if (e != hipSuccess) fprintf(stderr, "kernel_launch: cooperative launch failed: %s (grid %d)\n", hipGetErrorString(e), grid);
}
```
